# Optimizing an MI355X kernel written in HIP

```python
import jax, jax.numpy as jnp
from jax import lax
import numpy as np

D_MODEL = 2048
BATCH = 4
SEQ = 8192
DEPTH = 1
DEC_BATCH = 1
DEC_SEQ = 16384
PAST_LEN = 128

GRID_W = 64
HEAD_DIM = 128
NA_HEADS = 8
NA_WIN_H = 8
NA_WIN_W = 16
GQA_Q_HEADS = 8
GQA_KV_HEADS = 2
ROPE_THETA = 10000.0
ROPE_AXIS_PAIRS = HEAD_DIM // 4
Q_BLOCK = 128
N_MEM = 256
CROSS_HEADS = 4
D_FF = 4 * D_MODEL
EPS = 1e-6
NEG_INF = -1e30
NA_W = NA_HEADS * HEAD_DIM
GQA_QW = GQA_Q_HEADS * HEAD_DIM
GQA_KVW = GQA_KV_HEADS * HEAD_DIM
CROSS_W = CROSS_HEADS * HEAD_DIM
IN_SPLITS = (NA_W, NA_W, NA_W, GQA_QW, GQA_KVW, GQA_KVW, D_MODEL, D_MODEL)
D_IN = sum(IN_SPLITS)

kernel_name = 'hybrid_natten_gqa_xattn_encoder'


def _rmsnorm(x, g):
    xf = x.astype(jnp.float32)
    y = xf * lax.rsqrt(jnp.mean(xf * xf, axis=-1, keepdims=True) + EPS)
    return (y * g.astype(jnp.float32)).astype(x.dtype)


def _neighbourhood_attention(q, k, v, rpb):
    b, s, h, dh = q.shape
    rows = s // GRID_W
    kh = min(NA_WIN_H, rows)
    qg = q.reshape(b, rows, GRID_W, h, dh).transpose(1, 0, 2, 3, 4)
    kg = k.reshape(b, rows, GRID_W, h, dh)
    vg = v.reshape(b, rows, GRID_W, h, dh)
    cols = np.arange(GRID_W)
    col_start = np.clip(cols - NA_WIN_W // 2, 0, GRID_W - NA_WIN_W)
    col_mask = (cols[None, :] >= col_start[:, None]) & (cols[None, :] < col_start[:, None] + NA_WIN_W)
    col_idx = np.clip(cols[None, :] - cols[:, None] + NA_WIN_W - 1, 0, 2 * NA_WIN_W - 2)
    band_mask = jnp.asarray(np.broadcast_to(col_mask[:, None, :], (GRID_W, kh, GRID_W)).reshape(GRID_W, kh * GRID_W))
    scale = dh ** -0.5

    def row_block(args):
        r, q_r = args
        start = jnp.clip(r - kh // 2, 0, rows - kh)
        k_r = lax.dynamic_slice_in_dim(kg, start, kh, axis=1).reshape(b, kh * GRID_W, h, dh)
        v_r = lax.dynamic_slice_in_dim(vg, start, kh, axis=1).reshape(b, kh * GRID_W, h, dh)
        ridx = start + jnp.arange(kh) - r + NA_WIN_H - 1
        bias = rpb[:, ridx][:, :, col_idx]
        bias = bias.transpose(0, 2, 1, 3).reshape(h, GRID_W, kh * GRID_W).astype(jnp.float32)
        sc = jnp.einsum('bqhd,bkhd->bhqk', q_r, k_r).astype(jnp.float32) * scale + bias
        sc = jnp.where(band_mask, sc, NEG_INF)
        p = jax.nn.softmax(sc, axis=-1).astype(v_r.dtype)
        return jnp.einsum('bhqk,bkhd->bqhd', p, v_r)

    out = lax.map(row_block, (jnp.arange(rows), qg))
    return out.transpose(1, 0, 2, 3, 4).reshape(b, s, h * dh)


def _axial_rope_tables(s):
    t = jnp.arange(s)
    row = (t // GRID_W).astype(jnp.float32)
    col = (t % GRID_W).astype(jnp.float32)
    inv_freq = ROPE_THETA ** (-jnp.arange(ROPE_AXIS_PAIRS, dtype=jnp.float32) / ROPE_AXIS_PAIRS)
    ang_r = (row[:, None] * inv_freq[None, :])[:, None, :]
    ang_c = (col[:, None] * inv_freq[None, :])[:, None, :]
    return jnp.cos(ang_r), jnp.sin(ang_r), jnp.cos(ang_c), jnp.sin(ang_c)


def _rope_axis(x, cos, sin):
    x1, x2 = jnp.split(x, 2, axis=-1)
    return jnp.concatenate([x1 * cos - x2 * sin, x2 * cos + x1 * sin], axis=-1)


def _axial_rope(x, tables):
    cos_r, sin_r, cos_c, sin_c = tables
    xf = x.astype(jnp.float32)
    xr, xc = jnp.split(xf, 2, axis=-1)
    y = jnp.concatenate([_rope_axis(xr, cos_r, sin_r), _rope_axis(xc, cos_c, sin_c)], axis=-1)
    return y.astype(x.dtype)


def _gqa_attention(q, k, v):
    b, s, hq, dh = q.shape
    hkv = k.shape[2]
    g = hq // hkv
    nb = s // Q_BLOCK
    scale = dh ** -0.5
    qb = q.reshape(b, nb, Q_BLOCK, hkv, g, dh).transpose(1, 0, 2, 3, 4, 5)

    def block(q_blk):
        sc = jnp.einsum('bqkgd,bskd->bkgqs', q_blk, k).astype(jnp.float32) * scale
        p = jax.nn.softmax(sc, axis=-1).astype(v.dtype)
        return jnp.einsum('bkgqs,bskd->bqkgd', p, v)

    out = lax.map(block, qb)
    return out.transpose(1, 0, 2, 3, 4, 5).reshape(b, s, hq * dh)


def _cross_attention(h, mem_h, w_cq, w_ckv, w_co):
    b, s, _ = h.shape
    m = mem_h.shape[1]
    q = (h @ w_cq).reshape(b, s, CROSS_HEADS, HEAD_DIM)
    k, v = jnp.split(mem_h @ w_ckv, 2, axis=-1)
    k = k.reshape(b, m, CROSS_HEADS, HEAD_DIM)
    v = v.reshape(b, m, CROSS_HEADS, HEAD_DIM)
    sc = jnp.einsum('bqhd,bmhd->bhqm', q, k).astype(jnp.float32) * (HEAD_DIM ** -0.5)
    p = jax.nn.softmax(sc, axis=-1).astype(v.dtype)
    o = jnp.einsum('bhqm,bmhd->bqhd', p, v).reshape(b, s, CROSS_W)
    return o @ w_co


def _trunk(x, mem, g_mix, w_in, rpb, g_q, g_k, w_pa, w_pb, w_o, g_cross, g_mem, w_cq, w_ckv, w_co,
           g_mlp, w_up, w_down, g_final):
    b, s, _ = x.shape
    tables = _axial_rope_tables(s)
    split_pts = [int(p) for p in np.cumsum(IN_SPLITS)[:-1]]
    for l in range(DEPTH):
        h = _rmsnorm(x, g_mix[l])
        z = h @ w_in[l]
        qa, ka, va, qb, kb, vb, ga, gb = jnp.split(z, split_pts, axis=-1)
        y_a = _neighbourhood_attention(qa.reshape(b, s, NA_HEADS, HEAD_DIM),
                                       ka.reshape(b, s, NA_HEADS, HEAD_DIM),
                                       va.reshape(b, s, NA_HEADS, HEAD_DIM), rpb[l]) @ w_pa[l]
        qb = _axial_rope(_rmsnorm(qb.reshape(b, s, GQA_Q_HEADS, HEAD_DIM), g_q[l]), tables)
        kb = _axial_rope(_rmsnorm(kb.reshape(b, s, GQA_KV_HEADS, HEAD_DIM), g_k[l]), tables)
        y_b = _gqa_attention(qb, kb, vb.reshape(b, s, GQA_KV_HEADS, HEAD_DIM)) @ w_pb[l]
        mixed = jax.nn.sigmoid(ga) * y_a + jax.nn.sigmoid(gb) * y_b
        x = x + mixed @ w_o[l]
        x = x + _cross_attention(_rmsnorm(x, g_cross[l]), _rmsnorm(mem, g_mem[l]), w_cq[l], w_ckv[l], w_co[l])
        hm = _rmsnorm(x, g_mlp[l]) @ w_up[l]
        x = x + jnp.square(jax.nn.relu(hm)) @ w_down[l]
    return _rmsnorm(x, g_final)


def setup_inputs(seed: int = 0) -> dict:
    key = jax.random.key(seed)
    ks = jax.random.split(key, 24)
    f32 = jnp.float32

    def w(k, shape, fan_in):
        return jax.random.normal(k, shape, f32) * (fan_in ** -0.5)

    def gain(k, shape):
        return 1.0 + 0.01 * jax.random.normal(k, shape, f32)

    return {
        'x_prompt': jax.random.normal(ks[0], (BATCH, SEQ, D_MODEL), f32),
        'x_sample': jax.random.normal(ks[1], (DEC_BATCH, DEC_SEQ, D_MODEL), f32),
        'mem_prompt': jax.random.normal(ks[2], (BATCH, N_MEM, D_MODEL), f32),
        'mem_sample': jax.random.normal(ks[3], (DEC_BATCH, N_MEM, D_MODEL), f32),
        'g_mix': gain(ks[4], (DEPTH, D_MODEL)),
        'w_in': w(ks[5], (DEPTH, D_MODEL, D_IN), D_MODEL),
        'rpb': 0.02 * jax.random.normal(ks[6], (DEPTH, NA_HEADS, 2 * NA_WIN_H - 1, 2 * NA_WIN_W - 1), f32),
        'g_q': gain(ks[7], (DEPTH, HEAD_DIM)),
        'g_k': gain(ks[8], (DEPTH, HEAD_DIM)),
        'w_pa': w(ks[9], (DEPTH, NA_W, D_MODEL), NA_W),
        'w_pb': w(ks[10], (DEPTH, GQA_QW, D_MODEL), GQA_QW),
        'w_o': w(ks[11], (DEPTH, D_MODEL, D_MODEL), D_MODEL),
        'g_cross': gain(ks[12], (DEPTH, D_MODEL)),
        'g_mem': gain(ks[13], (DEPTH, D_MODEL)),
        'w_cq': w(ks[14], (DEPTH, D_MODEL, CROSS_W), D_MODEL),
        'w_ckv': w(ks[15], (DEPTH, D_MODEL, 2 * CROSS_W), D_MODEL),
        'w_co': w(ks[16], (DEPTH, CROSS_W, D_MODEL), CROSS_W),
        'g_mlp': gain(ks[17], (DEPTH, D_MODEL)),
        'w_up': w(ks[18], (DEPTH, D_MODEL, D_FF), D_MODEL),
        'w_down': w(ks[19], (DEPTH, D_FF, D_MODEL), D_FF),
        'g_final': gain(ks[20], (D_MODEL,)),
    }


def reference(x_prompt, x_sample, mem_prompt, mem_sample, g_mix, w_in, rpb, g_q, g_k, w_pa, w_pb, w_o,
              g_cross, g_mem, w_cq, w_ckv, w_co, g_mlp, w_up, w_down, g_final):
    y_prompt = _trunk(x_prompt, mem_prompt, g_mix, w_in, rpb, g_q, g_k, w_pa, w_pb, w_o, g_cross, g_mem,
                      w_cq, w_ckv, w_co, g_mlp, w_up, w_down, g_final)
    y_sample = _trunk(x_sample, mem_sample, g_mix, w_in, rpb, g_q, g_k, w_pa, w_pb, w_o, g_cross, g_mem,
                      w_cq, w_ckv, w_co, g_mlp, w_up, w_down, g_final)
    return (y_prompt, y_sample)
```

```cpp
#include <hip/hip_runtime.h>
#include <hip/hip_bf16.h>
#include <hip/hip_cooperative_groups.h>
#include <cstdio>
#include <cstdint>
#include <cmath>
#include <type_traits>
namespace cg = cooperative_groups;

#ifndef MK_MULTI
#define MK_MULTI 0
#endif

#define LAS __attribute__((address_space(3)))
typedef unsigned short bf16_t;
typedef short bf16x8 __attribute__((ext_vector_type(8)));
typedef short s16x4 __attribute__((ext_vector_type(4)));
typedef float f32x2 __attribute__((ext_vector_type(2)));
typedef float f32x4 __attribute__((ext_vector_type(4)));
typedef float f32x16 __attribute__((ext_vector_type(16)));
typedef unsigned u32x2 __attribute__((ext_vector_type(2)));
typedef unsigned u32x4 __attribute__((ext_vector_type(4)));
typedef int i32x4 __attribute__((ext_vector_type(4)));
typedef int i32x8 __attribute__((ext_vector_type(8)));

constexpr int DM = 2048, NTOK = 49152, CH = 32768  , NCH = 2, DIN = 8704, DFF = 8192, NMEMROWS = 1280, CWID = 512;
constexpr float EPS = 1e-6f;
constexpr size_t MiB = 1u << 20;
constexpr size_t WS_SS = 0;
constexpr size_t WS_WIN = 1 * MiB, WS_WPA = 35 * MiB, WS_WPB = 39 * MiB, WS_WO = 43 * MiB, WS_WCQ = 51 * MiB, WS_WCKV = 53 * MiB,
                 WS_WCO = 57 * MiB, WS_WUP = 59 * MiB, WS_WDN = 91 * MiB, WS_MEMN = 123 * MiB, WS_MEMKV = 128 * MiB, WS_XB = 131 * MiB,
                 WS_QC = 323 * MiB, WS_Z = 371 * MiB, WS_ZEND = 915 * MiB, WS_XN8 = WS_XB + 96 * MiB  , WS_O8A = 916 * MiB, WS_O8B = 948 * MiB  , WS_END = 980 * MiB;
constexpr size_t Z_NAQ = 0, Z_NAK = (size_t)CH * 1024, Z_NAV = (size_t)2 * CH * 1024, Z_GQ = (size_t)3 * CH * 1024, Z_GK = (size_t)4 * CH * 1024,
                 Z_GV = Z_GK + (size_t)CH * 256, Z_GA = Z_GV + (size_t)CH * 256, Z_GB = Z_GA + (size_t)CH * 2048;
static_assert((Z_GB + (size_t)CH * 2048) * 2 <= WS_ZEND - WS_Z, "z region");
static_assert((size_t)CH * DFF * 2 <= WS_ZEND - WS_Z, "h overlay");
constexpr int W8_SHIFT = 5, OA_SHIFT = 4, OB_SHIFT = 5, MX_SHIFT = 4;

__device__ __forceinline__ unsigned cvt_pk_bf16(float lo, float hi) { unsigned r; asm volatile("v_cvt_pk_bf16_f32 %0, %1, %2" : "=v"(r) : "v"(lo), "v"(hi)); return r; }
__device__ __forceinline__ unsigned pack4_fp8(float a, float b, float c, float d) { int r = 0; r = __builtin_amdgcn_cvt_pk_fp8_f32(a, b, r, false); r = __builtin_amdgcn_cvt_pk_fp8_f32(c, d, r, true); return (unsigned)r; }
__device__ __forceinline__ float bf_lo(unsigned w) { return __uint_as_float(w << 16); }
__device__ __forceinline__ float bf_hi(unsigned w) { return __uint_as_float(w & 0xffff0000u); }
__device__ __forceinline__ float sigmoidf_(float x) { return __builtin_amdgcn_rcpf(1.0f + __builtin_amdgcn_exp2f(-1.4426950408889634f * x)); }

namespace pg8 {
constexpr int BM = 256, BK = 64, HALF = 128, HTB = HALF * BK * 2, STAGE_BYTES = 8 * HTB, NXCD = 8, WGM = 8;
__host__ __device__ __forceinline__ int lds_byte(int r, int c) { const int st = (r >> 4) * 2 + (c >> 5), rr = r & 15, cc = c & 31, ob = rr * 64 + cc * 2; return st * 1024 + (ob ^ (((ob >> 9) & 1) << 5)); }
__host__ __device__ __forceinline__ void stage_rc(int b, int& R, int& C) { const int st = b / 1024, sb = b % 1024, swz = sb ^ (((sb >> 9) & 1) << 5); R = (st >> 1) * 16 + swz / 64; C = (st & 1) * 32 + (swz % 64) / 2; }
__host__ __device__ __forceinline__ int perm32(int rho) { const int n = rho >> 4, i = rho & 15; return 8 * (i >> 2) + 4 * n + (i & 3); }
struct Unit { int pm, pn; };
struct Gemm { const bf16_t* A; const bf16_t* Bt; int M, N, K, lda; int xshift; };
struct StaticOrder {
    int nM, nN, nwg, G, c;
    __device__ void init(int M, int N, int G_, int c_) { nM = M / BM; nN = N / BM; nwg = nM * nN; G = G_; c = c_; }
    __device__ bool next(int i, Unit& u) const {
        const long L = (long)i * G + c; if (L >= nwg) return false;
        int wgid = (int)L; { const int q = nwg / NXCD, r = nwg % NXCD, xcd = wgid % NXCD, off = wgid / NXCD; wgid = (xcd < r ? xcd * (q + 1) : r * (q + 1) + (xcd - r) * q) + off; }
        const int nig = WGM * nN, gid = wgid / nig, fm = gid * WGM, gsz = (nM - fm) < WGM ? (nM - fm) : WGM;
        u.pm = fm + ((wgid % nig) % gsz); u.pn = (wgid % nig) / gsz; return true;
    }
};

struct EpiB {
    static constexpr bool PERM = true;
    bf16_t* O; int ldc; int route; const float* ss; int act;
    __device__ __forceinline__ void operator()(const f32x4 (&acc)[2][2][4][2], const Unit& u, int wr, int wc, int fr, int fq) const {
        const int row0 = u.pm * BM + wr * 64 + fr; bf16_t* base = O; int ld = ldc, colt = u.pn * BM;
        if (route) { const int pn = u.pn;
            if (pn < 16) { base += (size_t)(pn >> 2) * ((size_t)CH * 1024); ld = 1024; colt = (pn & 3) * 256; }
            else if (pn < 18) { base += Z_GK + (size_t)(pn - 16) * ((size_t)CH * 256); ld = 256; colt = 0; }
            else { base += Z_GA + (size_t)((pn - 18) >> 3) * ((size_t)CH * 2048); ld = 2048; colt = ((pn - 18) & 7) * 256; } }
        const int col0 = colt + wc * 32 + 8 * fq;
#pragma unroll
        for (int ai = 0; ai < 2; ++ai)
#pragma unroll
            for (int m = 0; m < 4; ++m) { const int row = row0 + ai * HALF + m * 16; float sc = 1.f;
                if (ss) sc = __builtin_amdgcn_rsqf(ss[row] * (1.0f / DM) + EPS);
                bf16_t* rowp = base + (size_t)row * ld + col0;
#pragma unroll
                for (int bj = 0; bj < 2; ++bj) { f32x4 v0 = acc[ai][bj][m][0] * sc, v1 = acc[ai][bj][m][1] * sc;
                    if (act) {
#pragma unroll
                        for (int e = 0; e < 4; ++e) { float a = fmaxf(v0[e], 0.f), b = fmaxf(v1[e], 0.f); v0[e] = a * a; v1[e] = b * b; } }
                    u32x4 w; w.x = cvt_pk_bf16(v0[0], v0[1]); w.y = cvt_pk_bf16(v0[2], v0[3]); w.z = cvt_pk_bf16(v1[0], v1[1]); w.w = cvt_pk_bf16(v1[2], v1[3]);
                    *(u32x4*)(rowp + bj * HALF) = w; } }
    }
};
struct EpiGate {
    static constexpr bool PERM = true;
    const bf16_t* G; bf16_t* T; unsigned char* M8; int second;
    __device__ __forceinline__ void ldgrp(u32x4 (&gg)[2], u32x4 (&tt)[2], size_t ro) const {
#pragma unroll
        for (int bj = 0; bj < 2; ++bj) { gg[bj] = *(const u32x4*)(G + ro + bj * HALF); if (second) tt[bj] = *(const u32x4*)(T + ro + bj * HALF); else tt[bj] = (u32x4){0u, 0u, 0u, 0u}; }
    }
    __device__ __forceinline__ void operator()(const f32x4 (&acc)[2][2][4][2], const Unit& u, int wr, int wc, int fr, int fq) const {
        const int row0 = u.pm * BM + wr * 64 + fr, col0 = u.pn * BM + wc * 32 + 8 * fq;
        u32x4 gg[2], tt[2], gn[2], tn[2];
        ldgrp(gg, tt, (size_t)row0 * 2048 + col0);
#pragma unroll
        for (int gi = 0; gi < 8; ++gi) { const int ai = gi >> 2, m = gi & 3; const size_t ro = (size_t)(row0 + ai * HALF + m * 16) * 2048 + col0;
            if (gi < 7) ldgrp(gn, tn, (size_t)(row0 + ((gi + 1) >> 2) * HALF + ((gi + 1) & 3) * 16) * 2048 + col0);
#pragma unroll
            for (int bj = 0; bj < 2; ++bj) { const u32x4 g = gg[bj];
                f32x4 v0 = acc[ai][bj][m][0], v1 = acc[ai][bj][m][1];
                v0[0] *= sigmoidf_(bf_lo(g.x)); v0[1] *= sigmoidf_(bf_hi(g.x)); v0[2] *= sigmoidf_(bf_lo(g.y)); v0[3] *= sigmoidf_(bf_hi(g.y));
                v1[0] *= sigmoidf_(bf_lo(g.z)); v1[1] *= sigmoidf_(bf_hi(g.z)); v1[2] *= sigmoidf_(bf_lo(g.w)); v1[3] *= sigmoidf_(bf_hi(g.w));
                if (second) { const u32x4 t = tt[bj];
                    v0[0] += bf_lo(t.x); v0[1] += bf_hi(t.x); v0[2] += bf_lo(t.y); v0[3] += bf_hi(t.y);
                    v1[0] += bf_lo(t.z); v1[1] += bf_hi(t.z); v1[2] += bf_lo(t.w); v1[3] += bf_hi(t.w);
                    constexpr float MS = (float)(1 << MX_SHIFT); v0 = v0 * MS; v1 = v1 * MS;
                    u32x2 w; w.x = pack4_fp8(v0[0], v0[1], v0[2], v0[3]); w.y = pack4_fp8(v1[0], v1[1], v1[2], v1[3]);
                    *(u32x2*)(M8 + ro + bj * HALF) = w; }
                else { u32x4 w; w.x = cvt_pk_bf16(v0[0], v0[1]); w.y = cvt_pk_bf16(v0[2], v0[3]); w.z = cvt_pk_bf16(v1[0], v1[1]); w.w = cvt_pk_bf16(v1[2], v1[3]);
                    *(u32x4*)(T + ro + bj * HALF) = w; } }
#pragma unroll
            for (int bj = 0; bj < 2; ++bj) { gg[bj] = gn[bj]; tt[bj] = tn[bj]; }
        }
    }
};
template <bool XF>
struct EpiRes {
    static constexpr bool PERM = false;
    const float* Xf; const bf16_t* Xb; bf16_t* XB; float* ss;
    typedef typename std::conditional<XF, f32x4, u32x2>::type raw_t;
    __device__ __forceinline__ void ldgrp(raw_t (&r)[2][2], size_t ro) const {
#pragma unroll
        for (int bj = 0; bj < 2; ++bj)
#pragma unroll
            for (int n = 0; n < 2; ++n) { const size_t off = ro + bj * HALF + n * 16;
                if constexpr (XF) r[bj][n] = *(const f32x4*)(Xf + off); else r[bj][n] = *(const u32x2*)(Xb + off); }
    }
    __device__ __forceinline__ void operator()(const f32x4 (&acc)[2][2][4][2], const Unit& u, int wr, int wc, int fr, int fq) const {
        const int row0 = u.pm * BM + wr * 64 + fr, col0 = u.pn * BM + wc * 32 + 4 * fq;
        raw_t cur[2][2], nxt[2][2];
        ldgrp(cur, (size_t)row0 * 2048 + col0);
#pragma unroll
        for (int g = 0; g < 8; ++g) { const int ai = g >> 2, m = g & 3;
            if (g < 7) ldgrp(nxt, (size_t)(row0 + ((g + 1) >> 2) * HALF + ((g + 1) & 3) * 16) * 2048 + col0);
            const int row = row0 + ai * HALF + m * 16; const size_t ro = (size_t)row * 2048 + col0; float s = 0.f;
#pragma unroll
            for (int bj = 0; bj < 2; ++bj)
#pragma unroll
                for (int n = 0; n < 2; ++n) { const size_t off = ro + bj * HALF + n * 16;
                    f32x4 x;
                    if constexpr (XF) x = cur[bj][n]; else x = (f32x4){bf_lo(cur[bj][n].x), bf_hi(cur[bj][n].x), bf_lo(cur[bj][n].y), bf_hi(cur[bj][n].y)};
                    const f32x4 v = x + acc[ai][bj][m][n];
                    s += (v[0] * v[0] + v[1] * v[1]) + (v[2] * v[2] + v[3] * v[3]);
                    u32x2 w; w.x = cvt_pk_bf16(v[0], v[1]); w.y = cvt_pk_bf16(v[2], v[3]); *(u32x2*)(XB + off) = w; }
            s += __shfl_xor(s, 16); s += __shfl_xor(s, 32);
            if (fq == 0) unsafeAtomicAdd(ss + row, s);
#pragma unroll
            for (int bj = 0; bj < 2; ++bj)
#pragma unroll
                for (int n = 0; n < 2; ++n) cur[bj][n] = nxt[bj][n];
        }
    }
};

template <class Epi, class Sched, bool FP8 = false>
__device__ __forceinline__ void gemm_phase(LAS unsigned char* lds, const Gemm g, const Sched& S, const Epi& E) {
    int tid_ = threadIdx.x; asm volatile("" : "+v"(tid_));
    const int tid = tid_, wid = __builtin_amdgcn_readfirstlane(tid >> 6), lane = tid & 63, wr = wid >> 2, wc = wid & 3, fr = lane & 15, fq = lane >> 4;
    const int K = g.K, nt = K / BK, lda = g.lda;
    unsigned voffA[2], voffB[2];
#pragma unroll
    for (int i = 0; i < 2; ++i) { int R, C; stage_rc(tid * 16 + i * 8192, R, C); const int Rb = Epi::PERM ? ((R & ~31) + perm32(R & 31)) : R;
        voffA[i] = (unsigned)(R * lda + C) * 2u; voffB[i] = (unsigned)(Rb * K + C) * 2u; }
    const size_t kstep = (size_t)(BK * 2);
    const size_t hstepA = (size_t)HALF * lda * 2, hstepB = (size_t)HALF * K * 2, tstepA = 2 * hstepA, tstepB = 2 * hstepB;
    const unsigned ldsw = (unsigned)wid * 1024u;
    const int aoff = lds_byte(wr * 64 + fr, fq * 8), boff = lds_byte(wc * 32 + fr, fq * 8);
#define PG8_SA(b, h) (((b) * 2 + (h)) * HTB)
#define PG8_SB(b, h) ((4 + (b) * 2 + (h)) * HTB)
#define PG8_STAGE(bufoff, gbase, voff) do { _Pragma("unroll") for (int _i = 0; _i < 2; ++_i) \
        __builtin_amdgcn_global_load_lds((const unsigned*)((const char*)(gbase) + (voff)[_i]), (LAS unsigned*)(lds + (bufoff) + ldsw + _i * 8192), 16, 0, 0); } while (0)
#define PG8_LD2(p) __builtin_shufflevector(*(const LAS i32x4*)(p), *(const LAS i32x4*)((p) + 1024), 0, 1, 2, 3, 4, 5, 6, 7)
#define PG8_LDA(dst, b, h) do { _Pragma("unroll") for (int m = 0; m < 4; ++m) dst[m] = PG8_LD2(lds + PG8_SA(b, h) + aoff + m * 2048); } while (0)
#define PG8_LDB(dst, b, h) do { _Pragma("unroll") for (int n = 0; n < 2; ++n) dst[n] = PG8_LD2(lds + PG8_SB(b, h) + boff + n * 2048); } while (0)
#define PG8_LO(x) __builtin_bit_cast(bf16x8, __builtin_shufflevector(x, x, 0, 1, 2, 3))
#define PG8_HI(x) __builtin_bit_cast(bf16x8, __builtin_shufflevector(x, x, 4, 5, 6, 7))
#define PG8_MMA(ai, bj, At, Bt) do { __builtin_amdgcn_s_setprio(1); _Pragma("unroll") for (int m = 0; m < 4; ++m) _Pragma("unroll") for (int n = 0; n < 2; ++n) { \
        if constexpr (FP8) asm volatile("v_mfma_scale_f32_16x16x128_f8f6f4 %0, %1, %2, %0, %3, %4 op_sel_hi:[0,0,0]" : "+v"(acc[ai][bj][m][n]) : "v"(Bt[n]), "v"(At[m]), "v"(scl_w), "v"(scl_x)); \
        else { acc[ai][bj][m][n] = __builtin_amdgcn_mfma_f32_16x16x32_bf16(PG8_LO(Bt[n]), PG8_LO(At[m]), acc[ai][bj][m][n], 0, 0, 0); \
               acc[ai][bj][m][n] = __builtin_amdgcn_mfma_f32_16x16x32_bf16(PG8_HI(Bt[n]), PG8_HI(At[m]), acc[ai][bj][m][n], 0, 0, 0); } } \
        __builtin_amdgcn_s_setprio(0); } while (0)
#define PG8_WAIT_V(n) asm volatile("s_waitcnt vmcnt(" #n ")" ::: "memory")
#define PG8_WAIT_L(n) asm volatile("s_waitcnt lgkmcnt(" #n ")" ::: "memory")
#define PG8_BAR __builtin_amdgcn_s_barrier()
#define PG8_SCHED __builtin_amdgcn_sched_barrier(0)
    Unit cur, nxt; int ui = 0;
    if (!S.next(0, cur)) return;
    f32x4 acc[2][2][4][2];
#pragma unroll
    for (int a = 0; a < 2; ++a)
#pragma unroll
        for (int b = 0; b < 2; ++b)
#pragma unroll
            for (int m = 0; m < 4; ++m)
#pragma unroll
                for (int n = 0; n < 2; ++n) acc[a][b][m][n] = (f32x4){0.f, 0.f, 0.f, 0.f};
    i32x8 At[4], B0[2], B1[2];
    int scl_w = 0x7f7f7f7f - W8_SHIFT * 0x01010101, scl_x = 0x7f7f7f7f - g.xshift * 0x01010101; asm volatile("" : "+v"(scl_w), "+v"(scl_x)); (void)scl_w; (void)scl_x;
    const char* cA = (const char*)g.A + (size_t)cur.pm * tstepA; const char* cB = (const char*)g.Bt + (size_t)cur.pn * tstepB;
    PG8_STAGE(PG8_SB(0, 0), cB, voffB); PG8_STAGE(PG8_SB(0, 1), cB + hstepB, voffB); PG8_STAGE(PG8_SA(0, 0), cA, voffA); PG8_STAGE(PG8_SA(0, 1), cA + hstepA, voffA);
    if (wr == 1) PG8_BAR;
    PG8_WAIT_V(2); PG8_BAR;
    PG8_STAGE(PG8_SB(1, 0), cB + kstep, voffB); PG8_STAGE(PG8_SA(1, 0), cA + kstep, voffA); PG8_STAGE(PG8_SB(1, 1), cB + hstepB + kstep, voffB);
    PG8_WAIT_V(6); PG8_BAR;
    for (;;) {
        const bool has_next = S.next(ui + 1, nxt);
        const char* nA = has_next ? (const char*)g.A + (size_t)nxt.pm * tstepA : cA; const char* nB = has_next ? (const char*)g.Bt + (size_t)nxt.pn * tstepB : cB;
        for (int t = 0; t < nt; t += 2) {
            const bool last = (t == nt - 2);
            const char* a1 = cA + (size_t)(t + 1) * kstep;
            const char* a2 = last ? nA : cA + (size_t)(t + 2) * kstep; const char* b2 = last ? nB : cB + (size_t)(t + 2) * kstep;
            const char* a3 = a2 + kstep; const char* b3 = b2 + kstep;
            PG8_LDB(B0, 0, 0); PG8_LDB(B1, 0, 1); PG8_SCHED; PG8_LDA(At, 0, 0); PG8_STAGE(PG8_SA(1, 1), a1 + hstepA, voffA);
            PG8_WAIT_V(8); PG8_WAIT_L(0); PG8_BAR; PG8_MMA(0, 0, At, B0); PG8_MMA(0, 1, At, B1); PG8_BAR; PG8_SCHED;
            PG8_LDA(At, 0, 1); PG8_STAGE(PG8_SB(0, 0), b2, voffB); PG8_STAGE(PG8_SB(0, 1), b2 + hstepB, voffB); PG8_STAGE(PG8_SA(0, 0), a2, voffA);
            PG8_WAIT_V(8); PG8_WAIT_L(0); PG8_BAR; PG8_MMA(1, 0, At, B0); PG8_MMA(1, 1, At, B1); PG8_BAR; PG8_SCHED;
            PG8_LDB(B0, 1, 0); PG8_LDB(B1, 1, 1); PG8_SCHED; PG8_LDA(At, 1, 0); PG8_STAGE(PG8_SA(0, 1), a2 + hstepA, voffA);
            PG8_WAIT_V(8); PG8_WAIT_L(0); PG8_BAR; PG8_MMA(0, 0, At, B0); PG8_MMA(0, 1, At, B1); PG8_BAR; PG8_SCHED;
            PG8_LDA(At, 1, 1); PG8_STAGE(PG8_SB(1, 0), b3, voffB); PG8_STAGE(PG8_SB(1, 1), b3 + hstepB, voffB); PG8_STAGE(PG8_SA(1, 0), a3, voffA);
            PG8_WAIT_V(8); PG8_WAIT_L(0); PG8_BAR; PG8_MMA(1, 0, At, B0); PG8_MMA(1, 1, At, B1); PG8_BAR; PG8_SCHED;
        }
        if (wr == 0) PG8_BAR;
        if constexpr (FP8) asm volatile("s_nop 15\n\ts_nop 15" ::: "memory");
        E(acc, cur, wr, wc, fr, fq);
        if (!has_next) break;
#pragma unroll
        for (int a = 0; a < 2; ++a)
#pragma unroll
            for (int b = 0; b < 2; ++b)
#pragma unroll
                for (int m = 0; m < 4; ++m)
#pragma unroll
                    for (int n = 0; n < 2; ++n) acc[a][b][m][n] = (f32x4){0.f, 0.f, 0.f, 0.f};
        cur = nxt; cA = nA; cB = nB; ++ui;
        if (wr == 1) PG8_BAR;
    }
    PG8_WAIT_V(0);
    PG8_BAR;
#undef PG8_SA
#undef PG8_SB
#undef PG8_STAGE
#undef PG8_LDA
#undef PG8_LDB
#undef PG8_MMA
#undef PG8_LD2
#undef PG8_LO
#undef PG8_HI
#undef PG8_WAIT_V
#undef PG8_WAIT_L
#undef PG8_BAR
#undef PG8_SCHED
}
}

namespace att {
constexpr int D = 128, NW = 8, QBLK = 32, KVBLK = 64;
constexpr float SCALE = 0.088388347648318440f;
constexpr int SHM_V = KVBLK * D * 2, SHM_K = KVBLK * D * 2, SHM_ATTN = 2 * SHM_V + 2 * SHM_K + NW * 64 * 4;
constexpr int NA_TBL_OFF = SHM_ATTN, NA_TBL_PAD = 48, NA_TBL_FLOATS = 48 + 15 * 32 + 96, ATT_LDS = NA_TBL_OFF + NA_TBL_FLOATS * 4;
#define KSWZ(row, colB) ((row) * 256 + ((colB) ^ (((row) & 7) << 4)))
#define SBAR() __builtin_amdgcn_sched_barrier(0)
__device__ __forceinline__ int crow(int r, int hi) { return (r & 3) + 8 * (r >> 2) + 4 * hi; }
__device__ __forceinline__ bf16x8 ld8(const bf16_t* p) { return *reinterpret_cast<const bf16x8*>(p); }

template <int THRV = 8>
__device__ __forceinline__ void partialSM(f32x16& p0, f32x16& p1, float& m_reg, float& mn, float& alpha) {
  constexpr float C = SCALE * 1.4426950408889634f; constexpr float THR = (float)THRV;
  float pmax = p0[0];
#pragma unroll
  for (int r = 1; r < 16; ++r) pmax = fmaxf(pmax, p0[r]);
#pragma unroll
  for (int r = 0; r < 16; ++r) pmax = fmaxf(pmax, p1[r]);
  { auto rr = __builtin_amdgcn_permlane32_swap(__float_as_uint(pmax), __float_as_uint(pmax), false, false);
    pmax = fmaxf(__uint_as_float(rr[0]), __uint_as_float(rr[1])); }
  if (__builtin_expect(__all(pmax - m_reg <= THR / SCALE), 1)) { mn = m_reg; alpha = 1.f; }
  else { mn = fmaxf(m_reg, pmax); alpha = __builtin_amdgcn_exp2f((m_reg - mn) * C); m_reg = mn; }
  float mnC = -mn * C;
#pragma unroll
  for (int r = 0; r < 16; ++r) p0[r] = fmaf(p0[r], C, mnC);
#pragma unroll
  for (int r = 0; r < 16; ++r) p1[r] = fmaf(p1[r], C, mnC);
#pragma unroll
  for (int r = 0; r < 16; ++r) p0[r] = __builtin_amdgcn_exp2f(p0[r]);
}
__device__ __forceinline__ void finishSM(f32x16& p0, f32x16& p1, float alpha, float& l_reg, bf16x8& pa0, bf16x8& pa1, bf16x8& pa2, bf16x8& pa3) {
#pragma unroll
  for (int r = 0; r < 16; ++r) p1[r] = __builtin_amdgcn_exp2f(p1[r]);
  float ps = 0;
#pragma unroll
  for (int r = 0; r < 16; ++r) ps += p0[r];
#pragma unroll
  for (int r = 0; r < 16; ++r) ps += p1[r];
  { auto rr = __builtin_amdgcn_permlane32_swap(__float_as_uint(ps), __float_as_uint(ps), false, false);
    ps = __uint_as_float(rr[0]) + __uint_as_float(rr[1]); }
  l_reg = l_reg * alpha + ps;
#define PK4(P, BASE, OUT) do { unsigned a0 = cvt_pk_bf16(P[BASE + 0], P[BASE + 1]), a1 = cvt_pk_bf16(P[BASE + 2], P[BASE + 3]);   \
    unsigned b0 = cvt_pk_bf16(P[BASE + 4], P[BASE + 5]), b1 = cvt_pk_bf16(P[BASE + 6], P[BASE + 7]);                              \
    auto r0 = __builtin_amdgcn_permlane32_swap(a0, b0, false, false); auto r1 = __builtin_amdgcn_permlane32_swap(a1, b1, false, false); \
    u32x4 w = {r0[0], r1[0], r0[1], r1[1]}; OUT = *reinterpret_cast<bf16x8*>(&w); } while (0)
  PK4(p0, 0, pa0); PK4(p0, 8, pa1); PK4(p1, 0, pa2); PK4(p1, 8, pa3);
#undef PK4
}
__device__ __forceinline__ void qkt(f32x16& p0, f32x16& p1, const bf16_t* Ks, const bf16x8* qr, int r32, int hi) {
  p0 = f32x16{}; p1 = f32x16{};
#pragma unroll
  for (int d0 = 0; d0 < 8; ++d0) { int cb = (d0 * 16 + hi * 8) * 2;
    bf16x8 b0 = *reinterpret_cast<const bf16x8*>((const char*)Ks + KSWZ(r32, cb));
    bf16x8 b1 = *reinterpret_cast<const bf16x8*>((const char*)Ks + KSWZ(32 + r32, cb));
    p0 = __builtin_amdgcn_mfma_f32_32x32x16_bf16(b0, qr[d0], p0, 0, 0, 0);
    p1 = __builtin_amdgcn_mfma_f32_32x32x16_bf16(b1, qr[d0], p1, 0, 0, 0); }
}
__device__ __forceinline__ int v_st(int k, int c) { const int kk = (k & ~0xC) | ((k & 4) << 1) | ((k & 8) >> 1); return ((kk >> 3) * 4 + (c >> 5)) * 512 + ((kk & 7) * 32 + (c & 31)) * 2; }
__device__ __forceinline__ int v_rd_base(int lane) { return ((lane & 3) << 3) | (((lane >> 2) & 3) << 6) | (((lane >> 4) & 1) << 5) | (((lane >> 5) & 1) << 8); }
constexpr int v_rd_off(int d0, int ks, int half) { return d0 * 512 + ks * 4096 + half * 2048; }
template <int OFF> __device__ __forceinline__ s16x4 tr_read(int vb) {
  s16x4 r; asm volatile("ds_read_b64_tr_b16 %0, %1 offset:%2" : "=&v"(r) : "v"(vb), "i"(OFF) : "memory"); return r;
}
template <int D0> __device__ __forceinline__ void pv_one(f32x16& od, int vb, bf16x8 pa0, bf16x8 pa1, bf16x8 pa2, bf16x8 pa3) {
  const s16x4 l0 = tr_read<v_rd_off(D0, 0, 0)>(vb), h0 = tr_read<v_rd_off(D0, 0, 1)>(vb), l1 = tr_read<v_rd_off(D0, 1, 0)>(vb), h1 = tr_read<v_rd_off(D0, 1, 1)>(vb);
  const s16x4 l2 = tr_read<v_rd_off(D0, 2, 0)>(vb), h2 = tr_read<v_rd_off(D0, 2, 1)>(vb), l3 = tr_read<v_rd_off(D0, 3, 0)>(vb), h3 = tr_read<v_rd_off(D0, 3, 1)>(vb);
  asm volatile("s_waitcnt lgkmcnt(0)" ::: "memory"); SBAR();
#define PK(L, H) (bf16x8){L[0], L[1], L[2], L[3], H[0], H[1], H[2], H[3]}
  od = __builtin_amdgcn_mfma_f32_32x32x16_bf16(pa0, PK(l0, h0), od, 0, 0, 0);
  od = __builtin_amdgcn_mfma_f32_32x32x16_bf16(pa1, PK(l1, h1), od, 0, 0, 0);
  od = __builtin_amdgcn_mfma_f32_32x32x16_bf16(pa2, PK(l2, h2), od, 0, 0, 0);
  od = __builtin_amdgcn_mfma_f32_32x32x16_bf16(pa3, PK(l3, h3), od, 0, 0, 0);
#undef PK
}
__device__ __forceinline__ void pv_d0(f32x16* o, int vb, bf16x8 pa0, bf16x8 pa1, bf16x8 pa2, bf16x8 pa3) {
  pv_one<0>(o[0], vb, pa0, pa1, pa2, pa3); pv_one<1>(o[1], vb, pa0, pa1, pa2, pa3); pv_one<2>(o[2], vb, pa0, pa1, pa2, pa3); pv_one<3>(o[3], vb, pa0, pa1, pa2, pa3);
}
struct NaCtx { int r, rs, c, cs, kr0; const LAS float* tbl; };
__device__ __forceinline__ void na_mask(f32x16& p0, f32x16& p1, const NaCtx& n, int tile, int hi) {
  const int kr = n.kr0 + tile; const bool vrow = (kr >= n.rs) && (kr < n.rs + 8);
  int dr = kr - n.r + 7; dr = dr < 0 ? 0 : (dr > 14 ? 14 : dr);
  const LAS float* t = n.tbl + dr * 32 + 15 - n.c;
  const float NEG = -INFINITY;
  const int d0 = 4 * hi - n.cs;
#pragma unroll
  for (int rr = 0; rr < 16; ++rr) { const int kq = (rr & 3) + 8 * (rr >> 2);
    const bool ok0 = vrow && ((unsigned)(kq + d0) < 16u), ok1 = vrow && ((unsigned)(kq + 32 + d0) < 16u);
    const float b0 = t[kq + 4 * hi], b1 = t[kq + 4 * hi + 32];
    p0[rr] = ok0 ? p0[rr] + b0 : NEG; p1[rr] = ok1 ? p1[rr] + b1 : NEG;
    if ((rr & 3) == 3) asm volatile("" ::: "memory"); }
}

template <int LDQ, int LDK, int LDO, bool NA, int OSH = -1>
__device__ __forceinline__ void attn_body(const bf16_t* Qb, const bf16_t* __restrict__ Kh, const bf16_t* __restrict__ Vh, bf16_t* Ob, int seq, char* lds, const NaCtx& na) {
  int tid_ = threadIdx.x; asm volatile("" : "+v"(tid_));
  const int tid = tid_, wid = tid >> 6, lane = tid & 63, r32 = lane & 31, hi = lane >> 5;
  bf16_t* V_lds = (bf16_t*)lds; bf16_t* K_lds = (bf16_t*)(lds + 2 * SHM_V);
  float* ws = (float*)(lds + 2 * SHM_V + 2 * SHM_K) + wid * 64; float* li_l = ws; float* al_l = ws + 32;
  float m_reg = -1e30f, l_reg = 0; f32x16 o[4] = {}; bf16x8 qr[8];
  const bf16_t* Qw = Qb + (long)(wid * QBLK + r32) * LDQ + hi * 8;
#pragma unroll
  for (int d0 = 0; d0 < 8; ++d0) qr[d0] = ld8(Qw + d0 * 16);
  const int sr = tid >> 4, sc = (tid & 15) * 8, vst0 = v_st(sr, sc), vst1 = v_st(32 + sr, sc);
  const int vb0 = (int)(uintptr_t)V_lds + v_rd_base(lane);
  struct { bf16x8 vs0, vs1, ks0, ks1; } sr_[2];
#define SLOAD(i, k0) do { sr_[i].vs0 = ld8(&Vh[(long)((k0) + sr) * LDK + sc]); sr_[i].vs1 = ld8(&Vh[(long)((k0) + 32 + sr) * LDK + sc]); \
    sr_[i].ks0 = ld8(&Kh[(long)((k0) + sr) * LDK + sc]); sr_[i].ks1 = ld8(&Kh[(long)((k0) + 32 + sr) * LDK + sc]); } while (0)
#define SWRITE(b, i) do { *(bf16x8*)((char*)V_lds + (b) * SHM_V + vst0) = sr_[i].vs0;          \
    *(bf16x8*)((char*)V_lds + (b) * SHM_V + vst1) = sr_[i].vs1; int kc = sc * 2;               \
    *(bf16x8*)((char*)K_lds + (b) * SHM_K + KSWZ(sr, kc)) = sr_[i].ks0;                       \
    *(bf16x8*)((char*)K_lds + (b) * SHM_K + KSWZ(32 + sr, kc)) = sr_[i].ks1; } while (0)
#define SWAIT() asm volatile("s_waitcnt vmcnt(4)" ::: "memory")
#define RESC(a) do { if (__any((a) < 1.f)) { if (hi == 0) al_l[r32] = (a); asm volatile("s_waitcnt lgkmcnt(0)" ::: "memory"); \
    _Pragma("unroll") for (int d = 0; d < 4; ++d) _Pragma("unroll") for (int r = 0; r < 16; ++r) o[d][r] *= al_l[crow(r, hi)]; } } while (0)
#define NAM(P0, P1, t) do { if constexpr (NA) { SBAR(); na_mask(P0, P1, na, (t), hi); SBAR(); } } while (0)
  f32x16 pA0, pA1, pB0, pB1; float mnA, mnB, alA, alB; bf16x8 pa0, pa1, pa2, pa3; const int NT = seq / KVBLK;
  if (wid >= 4) __builtin_amdgcn_s_setprio(1);
  constexpr int SE = 0, SO = 1;
  SLOAD(SE, 0); asm volatile("s_waitcnt vmcnt(0)" ::: "memory"); SWRITE(0, SE); __syncthreads();
  qkt(pA0, pA1, K_lds, qr, r32, hi); NAM(pA0, pA1, 0); partialSM(pA0, pA1, m_reg, mnA, alA);
  SLOAD(SO, KVBLK); if (2 < NT) SLOAD(SE, 2 * KVBLK);
  SWAIT(); SWRITE(1, SO); __syncthreads();
  for (int j = 1; j + 1 < NT; j += 2) {
    SBAR(); qkt(pB0, pB1, (bf16_t*)((char*)K_lds + SHM_K), qr, r32, hi);
    finishSM(pA0, pA1, alA, l_reg, pa0, pa1, pa2, pa3); SBAR();
    SLOAD(SO, (j + 2) * KVBLK); SBAR();
    pv_d0(o, vb0, pa0, pa1, pa2, pa3); NAM(pB0, pB1, j); partialSM(pB0, pB1, m_reg, mnB, alB);
    __syncthreads(); SWAIT(); SWRITE(0, SE);
    RESC(alB); __syncthreads();
    SBAR(); qkt(pA0, pA1, K_lds, qr, r32, hi);
    finishSM(pB0, pB1, alB, l_reg, pa0, pa1, pa2, pa3); SBAR();
    if (j + 3 < NT) SLOAD(SE, (j + 3) * KVBLK); SBAR();
    pv_d0(o, vb0 + (int)SHM_V, pa0, pa1, pa2, pa3); NAM(pA0, pA1, j + 1); partialSM(pA0, pA1, m_reg, mnA, alA);
    __syncthreads(); SWAIT(); SWRITE(1, SO);
    RESC(alA); __syncthreads();
  }
  SBAR(); qkt(pB0, pB1, (bf16_t*)((char*)K_lds + SHM_K), qr, r32, hi);
  finishSM(pA0, pA1, alA, l_reg, pa0, pa1, pa2, pa3); SBAR();
  pv_d0(o, vb0, pa0, pa1, pa2, pa3); NAM(pB0, pB1, NT - 1); partialSM(pB0, pB1, m_reg, mnB, alB);
  __syncthreads(); RESC(alB);
  finishSM(pB0, pB1, alB, l_reg, pa0, pa1, pa2, pa3); SBAR();
  pv_d0(o, vb0 + (int)SHM_V, pa0, pa1, pa2, pa3);
  if (hi == 0) li_l[r32] = l_reg; asm volatile("s_waitcnt lgkmcnt(0)" ::: "memory");
  float rli[16];
#pragma unroll
  for (int r = 0; r < 16; ++r) rli[r] = __builtin_amdgcn_rcpf(li_l[crow(r, hi)]);
  if constexpr (OSH >= 0) {
    unsigned char* Ow8 = (unsigned char*)Ob + (long)(wid * QBLK) * LDO;
#pragma unroll
    for (int r = 0; r < 16; ++r) { int orow = crow(r, hi); const float sc = rli[r] * (float)(1 << (OSH >= 0 ? OSH : 0));
#pragma unroll
      for (int d0 = 0; d0 < 4; ++d0) Ow8[(long)orow * LDO + d0 * 32 + r32] = (unsigned char)(__builtin_amdgcn_cvt_pk_fp8_f32(o[d0][r] * sc, 0.f, 0, false) & 0xff); }
  } else {
  bf16_t* Ow = Ob + (long)(wid * QBLK) * LDO;
#pragma unroll
  for (int r = 0; r < 16; ++r) { int orow = crow(r, hi);
#pragma unroll
    for (int d0 = 0; d0 < 4; ++d0) Ow[(long)orow * LDO + d0 * 32 + r32] = (bf16_t)(cvt_pk_bf16(o[d0][r] * rli[r], 0.f) & 0xffffu); }
  }
  __builtin_amdgcn_s_setprio(0);
#undef SLOAD
#undef SWRITE
#undef SWAIT
#undef RESC
#undef NAM
}

__device__ __forceinline__ int vt_pos(int l) { const int kk = l & 31; return 32 * ((l >> 2) & 1) + (kk & 3) + 4 * (kk >> 3) + 16 * (l >> 5); }
#define F8_MFMA(A, B, C) __builtin_amdgcn_mfma_scale_f32_32x32x64_f8f6f4(A, B, C, 0, 0, 0, 0x7f7f7f7f, 0, 0x7f7f7f7f)
#define F8_MFMA_QK(A, B, C) __builtin_amdgcn_mfma_scale_f32_32x32x64_f8f6f4(A, B, C, 0, 0, 0, 0x7f7f7f7f, 0, 0x7c7c7c7c)
constexpr float QPRE = SCALE * 1.4426950408889634f * 8.0f;
template <int THRV>
__device__ __forceinline__ void partialSM8(f32x16& p0, f32x16& p1, float& m_reg, float& mn, float& alpha) {
  constexpr float THR2 = (float)THRV * 1.4426950408889634f;
  float pmax = p0[0];
#pragma unroll
  for (int r = 1; r < 16; ++r) pmax = fmaxf(pmax, p0[r]);
#pragma unroll
  for (int r = 0; r < 16; ++r) pmax = fmaxf(pmax, p1[r]);
  { auto rr = __builtin_amdgcn_permlane32_swap(__float_as_uint(pmax), __float_as_uint(pmax), false, false);
    pmax = fmaxf(__uint_as_float(rr[0]), __uint_as_float(rr[1])); }
  if (__builtin_expect(__all(pmax - m_reg <= THR2), 1)) { mn = m_reg; alpha = 1.f; }
  else { mn = fmaxf(m_reg, pmax); alpha = __builtin_amdgcn_exp2f(m_reg - mn); m_reg = mn; }
  p0 = p0 - mn; p1 = p1 - mn;
#pragma unroll
  for (int r = 0; r < 16; ++r) p0[r] = __builtin_amdgcn_exp2f(p0[r]);
}
#define F8_CAT(lo, hi) __builtin_shufflevector(lo, hi, 0, 1, 2, 3, 4, 5, 6, 7)
__device__ __forceinline__ void qkt8(f32x16& p0, f32x16& p1, const char* Ks, const i32x8* q8, int r32, int hi) {
  const int g = (r32 >> 1) & 7;
  const char* k0 = Ks + r32 * 128; const char* k1 = k0 + 32 * 128;
#pragma unroll
  for (int j = 0; j < 2; ++j) { const int c0 = 4 * j + 2 * hi;
    const i32x8 a0 = F8_CAT(*(const i32x4*)(k0 + (((c0) ^ g) << 4)), *(const i32x4*)(k0 + (((c0 + 1) ^ g) << 4)));
    const i32x8 a1 = F8_CAT(*(const i32x4*)(k1 + (((c0) ^ g) << 4)), *(const i32x4*)(k1 + (((c0 + 1) ^ g) << 4)));
    if (j == 0) { p0 = F8_MFMA_QK(a0, q8[0], f32x16{}); p1 = F8_MFMA_QK(a1, q8[0], f32x16{}); }
    else { p0 = F8_MFMA_QK(a0, q8[1], p0); p1 = F8_MFMA_QK(a1, q8[1], p1); } }
}
__device__ __forceinline__ void pv8(f32x16* o, const char* Vs, i32x8 pa, int r32, int hi) {
#pragma unroll
  for (int db = 0; db < 4; ++db) { const int d = 32 * db + r32, f = (d >> 2) & 3; const char* vr = Vs + d * 64;
    const i32x8 b = F8_CAT(*(const i32x4*)(vr + (((2 * hi) ^ f) << 4)), *(const i32x4*)(vr + (((2 * hi + 1) ^ f) << 4)));
    o[db] = F8_MFMA(pa, b, o[db]); }
}
__device__ __forceinline__ void finishSM8(f32x16& p0, f32x16& p1, float alpha, float& l_reg, i32x8& pa) {
#pragma unroll
  for (int r = 0; r < 16; ++r) p1[r] = __builtin_amdgcn_exp2f(p1[r]);
  float ps;
  { typedef float f32x8_ __attribute__((ext_vector_type(8)));
    const f32x16 t = p0 + p1;
    const f32x8_ t8 = __builtin_shufflevector(t, t, 0, 1, 2, 3, 4, 5, 6, 7) + __builtin_shufflevector(t, t, 8, 9, 10, 11, 12, 13, 14, 15);
    const f32x4 t4 = __builtin_shufflevector(t8, t8, 0, 1, 2, 3) + __builtin_shufflevector(t8, t8, 4, 5, 6, 7);
    const f32x2 t2 = __builtin_shufflevector(t4, t4, 0, 1) + __builtin_shufflevector(t4, t4, 2, 3);
    ps = t2.x + t2.y; }
  { auto rr = __builtin_amdgcn_permlane32_swap(__float_as_uint(ps), __float_as_uint(ps), false, false);
    ps = __uint_as_float(rr[0]) + __uint_as_float(rr[1]); }
  l_reg = l_reg * alpha + ps;
#pragma unroll
  for (int w = 0; w < 4; ++w) { pa[w] = (int)pack4_fp8(p0[4 * w], p0[4 * w + 1], p0[4 * w + 2], p0[4 * w + 3]); pa[4 + w] = (int)pack4_fp8(p1[4 * w], p1[4 * w + 1], p1[4 * w + 2], p1[4 * w + 3]); }
}
constexpr int F8_KB = 8192, F8_LDS_V = 2 * F8_KB, F8_LDS_WS = 4 * F8_KB;
template <int LDQ, int LDK, int LDO, int OSH>
__device__ __forceinline__ void attn_body_f8(const unsigned char* Qb, const unsigned char* __restrict__ Kh, const unsigned char* __restrict__ VTh, long ldv, unsigned char* Ob, int seq, char* lds) {
  int tid_ = threadIdx.x; asm volatile("" : "+v"(tid_));
  const int tid = tid_, wid = tid >> 6, lane = tid & 63, r32 = lane & 31, hi = lane >> 5;
  char* K_lds = lds; char* V_lds = lds + F8_LDS_V;
  float* ws = (float*)(lds + F8_LDS_WS) + wid * 64; float* li_l = ws; float* al_l = ws + 32;
  float m_reg = -1e30f, l_reg = 0; f32x16 o[4] = {}; i32x8 q8[2];
  { const unsigned char* Qw = Qb + (long)(wid * QBLK + r32) * LDQ + 32 * hi;
#pragma unroll
    for (int j = 0; j < 2; ++j) q8[j] = F8_CAT(*(const i32x4*)(Qw + 64 * j), *(const i32x4*)(Qw + 64 * j + 16)); }
  const int krow = tid >> 3, kc = tid & 7, kst = krow * 128 + ((kc ^ ((krow >> 1) & 7)) << 4);
  const int vd = tid >> 2, vc = tid & 3, vst = vd * 64 + ((vc ^ ((vd >> 2) & 3)) << 4);
  const unsigned char* kg = Kh + (long)krow * LDK + 16 * kc; const unsigned char* vg = VTh + (long)vd * ldv + 16 * vc;
  struct { i32x4 ks, vs; } sr_[2];
#define SLOAD(i, k0) do { sr_[i].ks = *(const i32x4*)(kg + (long)(k0) * LDK); sr_[i].vs = *(const i32x4*)(vg + (k0)); } while (0)
#define SWRITE(b, i) do { *(i32x4*)(K_lds + (b) * F8_KB + kst) = sr_[i].ks; *(i32x4*)(V_lds + (b) * F8_KB + vst) = sr_[i].vs; } while (0)
#define SWAIT() asm volatile("s_waitcnt vmcnt(2)" ::: "memory")
#define RESC(a) do { if (__any((a) < 1.f)) { if (hi == 0) al_l[r32] = (a); asm volatile("s_waitcnt lgkmcnt(0)" ::: "memory"); \
    _Pragma("unroll") for (int d = 0; d < 4; ++d) _Pragma("unroll") for (int r = 0; r < 16; ++r) o[d][r] *= al_l[crow(r, hi)]; } } while (0)
#define PV8(b, pa) do { asm volatile("s_waitcnt lgkmcnt(0)" ::: "memory"); pv8(o, V_lds + (b) * F8_KB, pa, r32, hi); } while (0)
  f32x16 pA0, pA1, pB0, pB1; float mnA, mnB, alA, alB; i32x8 pa; const int NT = seq / KVBLK;
  if (wid >= 4) __builtin_amdgcn_s_setprio(1);
  constexpr int SE = 0, SO = 1;
  SLOAD(SE, 0); asm volatile("s_waitcnt vmcnt(0)" ::: "memory"); SWRITE(0, SE); __syncthreads();
  qkt8(pA0, pA1, K_lds, q8, r32, hi); partialSM8<5>(pA0, pA1, m_reg, mnA, alA);
  SLOAD(SO, KVBLK); if (2 < NT) SLOAD(SE, 2 * KVBLK);
  SWAIT(); SWRITE(1, SO); __syncthreads();
  for (int j = 1; j + 1 < NT; j += 2) {
    SBAR(); qkt8(pB0, pB1, K_lds + F8_KB, q8, r32, hi);
    finishSM8(pA0, pA1, alA, l_reg, pa); SBAR();
    SLOAD(SO, (j + 2) * KVBLK); SBAR();
    PV8(0, pa); partialSM8<5>(pB0, pB1, m_reg, mnB, alB);
    __syncthreads(); SWAIT(); SWRITE(0, SE);
    RESC(alB); __syncthreads();
    SBAR(); qkt8(pA0, pA1, K_lds, q8, r32, hi);
    finishSM8(pB0, pB1, alB, l_reg, pa); SBAR();
    if (j + 3 < NT) SLOAD(SE, (j + 3) * KVBLK); SBAR();
    PV8(1, pa); partialSM8<5>(pA0, pA1, m_reg, mnA, alA);
    __syncthreads(); SWAIT(); SWRITE(1, SO);
    RESC(alA); __syncthreads();
  }
  SBAR(); qkt8(pB0, pB1, K_lds + F8_KB, q8, r32, hi);
  finishSM8(pA0, pA1, alA, l_reg, pa); SBAR();
  PV8(0, pa); partialSM8<5>(pB0, pB1, m_reg, mnB, alB);
  __syncthreads(); RESC(alB);
  finishSM8(pB0, pB1, alB, l_reg, pa); SBAR();
  PV8(1, pa);
  if (hi == 0) li_l[r32] = l_reg; asm volatile("s_waitcnt lgkmcnt(0)" ::: "memory");
  float rli[16];
#pragma unroll
  for (int r = 0; r < 16; ++r) rli[r] = __builtin_amdgcn_rcpf(li_l[crow(r, hi)]);
  unsigned char* Ow8 = Ob + (long)(wid * QBLK) * LDO;
#pragma unroll
  for (int r = 0; r < 16; ++r) { int orow = crow(r, hi); const float sc = rli[r] * (float)(1 << OSH);
#pragma unroll
    for (int d0 = 0; d0 < 4; ++d0) Ow8[(long)orow * LDO + d0 * 32 + r32] = (unsigned char)(__builtin_amdgcn_cvt_pk_fp8_f32(o[d0][r] * sc, 0.f, 0, false) & 0xff); }
  __builtin_amdgcn_s_setprio(0);
#undef SLOAD
#undef SWRITE
#undef SWAIT
#undef RESC
#undef PV8
}
#undef F8_MFMA
#undef F8_MFMA_QK
#undef F8_CAT
#undef SBAR
}

constexpr int NWAVES = 8;
constexpr int LDS_BYTES = 135168;
static_assert(att::ATT_LDS <= LDS_BYTES && pg8::STAGE_BYTES <= LDS_BYTES, "LDS map");
constexpr int NPH = 1 + 5 * NCH + 3 + 2 * NCH + 1;

struct Args { const float* in[21]; float* out; unsigned char* ws; int ph_lo, ph_hi; };

__device__ __forceinline__ float wave_sum(float v) {
#pragma unroll
    for (int o = 1; o < 64; o <<= 1) v += __shfl_xor(v, o);
    return v;
}
__device__ __forceinline__ void transpose_item(const float* __restrict__ W, int K, int N, bf16_t* __restrict__ WT, const float* __restrict__ gain, LAS float* scr, int item, int lane) {
    const int nblk = N / 32, kb = item / nblk, nb = item % nblk, k0 = 64 * kb, n0 = 32 * nb;
    { const int kr = lane >> 3, n4 = (lane & 7) * 4; f32x4 w[8];
#pragma unroll
      for (int i = 0; i < 8; ++i) w[i] = *(const f32x4*)(W + (size_t)(k0 + 8 * i + kr) * N + n0 + n4);
#pragma unroll
      for (int i = 0; i < 8; ++i) { const int kk = 8 * i + kr; f32x4 v = w[i]; if (gain) v = v * gain[k0 + kk]; LAS float* d = scr + kk * 33 + n4; d[0] = v.x; d[1] = v.y; d[2] = v.z; d[3] = v.w; } }
    asm volatile("s_waitcnt lgkmcnt(0)" ::: "memory");
    const int c = lane & 7;
#pragma unroll
    for (int j = 0; j < 4; ++j) { const int n = (lane >> 3) + 8 * j; const LAS float* s = scr + (8 * c) * 33 + n;
        u32x4 o; o.x = cvt_pk_bf16(s[0 * 33], s[1 * 33]); o.y = cvt_pk_bf16(s[2 * 33], s[3 * 33]); o.z = cvt_pk_bf16(s[4 * 33], s[5 * 33]); o.w = cvt_pk_bf16(s[6 * 33], s[7 * 33]);
        *(u32x4*)(WT + (size_t)(n0 + n) * K + k0 + 8 * c) = o; }
    asm volatile("s_waitcnt lgkmcnt(0)" ::: "memory");
}
__device__ __forceinline__ void transpose_item_fp8(const float* __restrict__ W, int K, int N, unsigned char* __restrict__ WT, const float* __restrict__ gain, float mul, LAS float* scr, int item, int lane) {
    const int nblk = N / 32, kb = item / nblk, nb = item % nblk, k0 = 64 * kb, n0 = 32 * nb;
    { const int kr = lane >> 3, n4 = (lane & 7) * 4; f32x4 w[8];
#pragma unroll
      for (int i = 0; i < 8; ++i) w[i] = *(const f32x4*)(W + (size_t)(k0 + 8 * i + kr) * N + n0 + n4);
#pragma unroll
      for (int i = 0; i < 8; ++i) { const int kk = 8 * i + kr; f32x4 v = w[i] * mul; if (gain) v = v * gain[k0 + kk]; LAS float* d = scr + kk * 33 + n4; d[0] = v.x; d[1] = v.y; d[2] = v.z; d[3] = v.w; } }
    asm volatile("s_waitcnt lgkmcnt(0)" ::: "memory");
    const int c = lane & 3;
#pragma unroll
    for (int j = 0; j < 2; ++j) { const int n = (lane >> 2) + 16 * j; const LAS float* s = scr + (16 * c) * 33 + n;
        u32x4 o; o.x = pack4_fp8(s[0 * 33], s[1 * 33], s[2 * 33], s[3 * 33]); o.y = pack4_fp8(s[4 * 33], s[5 * 33], s[6 * 33], s[7 * 33]);
        o.z = pack4_fp8(s[8 * 33], s[9 * 33], s[10 * 33], s[11 * 33]); o.w = pack4_fp8(s[12 * 33], s[13 * 33], s[14 * 33], s[15 * 33]);
        *(u32x4*)(WT + (size_t)(n0 + n) * K + k0 + 16 * c) = o; }
    asm volatile("s_waitcnt lgkmcnt(0)" ::: "memory");
}
__device__ __forceinline__ void rms_row_to_fp8(const float* xrow, unsigned char* orow, int lane) {
    const f32x4* xr = (const f32x4*)xrow + lane;
    f32x4 v[8]; float s = 0.f;
#pragma unroll
    for (int j = 0; j < 8; ++j) { v[j] = xr[64 * j]; s += (v[j].x * v[j].x + v[j].y * v[j].y) + (v[j].z * v[j].z + v[j].w * v[j].w); }
    const float rr = __builtin_amdgcn_rsqf(wave_sum(s) * (1.f / DM) + EPS);
    unsigned* o4 = (unsigned*)orow + lane;
#pragma unroll
    for (int j = 0; j < 8; ++j) o4[64 * j] = pack4_fp8(v[j].x * rr, v[j].y * rr, v[j].z * rr, v[j].w * rr);
}
__device__ __forceinline__ void rms_row2_to_fp8(const float* xa, const float* xb, unsigned char* oa, unsigned char* ob, int lane) {
    const f32x4* pa = (const f32x4*)xa + lane; const f32x4* pb = (const f32x4*)xb + lane;
    f32x4 va[8], vb[8]; float sa = 0.f, sb = 0.f;
#pragma unroll
    for (int j = 0; j < 8; ++j) { va[j] = pa[64 * j]; vb[j] = pb[64 * j]; }
#pragma unroll
    for (int j = 0; j < 8; ++j) { sa += (va[j].x * va[j].x + va[j].y * va[j].y) + (va[j].z * va[j].z + va[j].w * va[j].w); sb += (vb[j].x * vb[j].x + vb[j].y * vb[j].y) + (vb[j].z * vb[j].z + vb[j].w * vb[j].w); }
    const float ra = __builtin_amdgcn_rsqf(wave_sum(sa) * (1.f / DM) + EPS), rb = __builtin_amdgcn_rsqf(wave_sum(sb) * (1.f / DM) + EPS);
    unsigned* qa = (unsigned*)oa + lane; unsigned* qb = (unsigned*)ob + lane;
#pragma unroll
    for (int j = 0; j < 8; ++j) { qa[64 * j] = pack4_fp8(va[j].x * ra, va[j].y * ra, va[j].z * ra, va[j].w * ra); qb[64 * j] = pack4_fp8(vb[j].x * rb, vb[j].y * rb, vb[j].z * rb, vb[j].w * rb); }
}
__device__ __forceinline__ void rms_row_to_bf16(const float* xrow, bf16_t* orow, int lane) {
    const f32x4* xr = (const f32x4*)xrow + lane;
    f32x4 v[8]; float s = 0.f;
#pragma unroll
    for (int j = 0; j < 8; ++j) { v[j] = xr[64 * j]; s += (v[j].x * v[j].x + v[j].y * v[j].y) + (v[j].z * v[j].z + v[j].w * v[j].w); }
    const float rr = __builtin_amdgcn_rsqf(wave_sum(s) * (1.f / DM) + EPS);
    u32x2* o8 = (u32x2*)orow + lane;
#pragma unroll
    for (int j = 0; j < 8; ++j) { u32x2 w; w.x = cvt_pk_bf16(v[j].x * rr, v[j].y * rr); w.y = cvt_pk_bf16(v[j].z * rr, v[j].w * rr); o8[64 * j] = w; }
}
__device__ __forceinline__ u32x4 rope_item(const u32x4 raw, const size_t e0, int W, int seq, const float* __restrict__ g, float mul) {
    const int tok = (int)(e0 / (size_t)W), d = (int)(e0 & 127);
    float x[8] = {bf_lo(raw.x), bf_hi(raw.x), bf_lo(raw.y), bf_hi(raw.y), bf_lo(raw.z), bf_hi(raw.z), bf_lo(raw.w), bf_hi(raw.w)};
    float ssq = 0.f;
#pragma unroll
    for (int e = 0; e < 8; ++e) ssq += x[e] * x[e];
    ssq += __shfl_xor(ssq, 1); ssq += __shfl_xor(ssq, 2); ssq += __shfl_xor(ssq, 4); ssq += __shfl_xor(ssq, 8);
    const float rr = __builtin_amdgcn_rsqf(ssq * (1.f / 128.f) + EPS);
    const f32x4 g0 = *(const f32x4*)(g + d), g1 = *(const f32x4*)(g + d + 4);
    x[0] *= rr * g0.x; x[1] *= rr * g0.y; x[2] *= rr * g0.z; x[3] *= rr * g0.w; x[4] *= rr * g1.x; x[5] *= rr * g1.y; x[6] *= rr * g1.z; x[7] *= rr * g1.w;
    const int s = tok % seq; const float pos = (float)((d < 64) ? (s >> 6) : (s & 63));
    const bool first = ((d & 63) < 32); const int fi0 = d & 31;
    float y[8];
#pragma unroll
    for (int e = 0; e < 8; ++e) { const float other = __shfl_xor(x[e], 4);
        const float invf = __builtin_amdgcn_exp2f(-(float)(fi0 + e) * 0.41524101186092029f);
        float rev = pos * invf * 0.15915494309189535f; rev -= rintf(rev);
        const float sn = __builtin_amdgcn_sinf(rev), cs = __builtin_amdgcn_cosf(rev);
        y[e] = (first ? (x[e] * cs - other * sn) : (x[e] * cs + other * sn)) * mul; }
    u32x4 w; w.x = pack4_fp8(y[0], y[1], y[2], y[3]); w.y = pack4_fp8(y[4], y[5], y[6], y[7]); w.z = 0u; w.w = 0u;
    return w;
}
__device__ __forceinline__ void rope_pass(const bf16_t* buf, unsigned char* out8, int W, int ntok, int seq, const float* __restrict__ g, float mul, int gw, int ngw, int lane) {
    const int nitems = (int)(((size_t)ntok * W) / 512);
    for (int it = gw; it < nitems; it += 4 * ngw) {
        size_t e[4]; u32x4 raw[4];
#pragma unroll
        for (int q = 0; q < 4; ++q) { const int iq = it + q * ngw; e[q] = (size_t)(iq < nitems ? iq : it) * 512 + (size_t)lane * 8; raw[q] = *(const u32x4*)(buf + e[q]); }
#pragma unroll
        for (int q = 0; q < 4; ++q) { const u32x4 w = rope_item(raw[q], e[q], W, seq, g, mul); if (it + q * ngw < nitems) { u32x2 o; o.x = w.x; o.y = w.y; *(u32x2*)(out8 + e[q]) = o; } }
    }
}
__device__ __forceinline__ void vt_pass(const bf16_t* gv, unsigned char* VT8, int ntok, int seq, int gw, int ngw, int lane) {
    const int nitems = (ntok / 64) * 2;
    for (int it = gw; it < nitems; it += ngw) {
        const int blk = it >> 1, kvh = it & 1, tok0 = blk * 64, b = tok0 / seq, s0 = tok0 % seq;
        const bf16_t* src = gv + (size_t)(tok0 + lane) * 256 + kvh * 128;
        unsigned char* dst = VT8 + ((size_t)(b * 2 + kvh) * 128) * (size_t)seq + s0 + att::vt_pos(lane);
        u32x4 raw[16];
#pragma unroll
        for (int c = 0; c < 16; ++c) raw[c] = *(const u32x4*)(src + 8 * c);
#pragma unroll
        for (int c = 0; c < 16; ++c) {
            const unsigned a = pack4_fp8(bf_lo(raw[c].x), bf_hi(raw[c].x), bf_lo(raw[c].y), bf_hi(raw[c].y)), d2 = pack4_fp8(bf_lo(raw[c].z), bf_hi(raw[c].z), bf_lo(raw[c].w), bf_hi(raw[c].w));
            unsigned char* dp = dst + (size_t)(8 * c) * seq;
            dp[0] = (unsigned char)(a & 0xff); dp[(size_t)seq] = (unsigned char)((a >> 8) & 0xff); dp[2 * (size_t)seq] = (unsigned char)((a >> 16) & 0xff); dp[3 * (size_t)seq] = (unsigned char)(a >> 24);
            dp[4 * (size_t)seq] = (unsigned char)(d2 & 0xff); dp[5 * (size_t)seq] = (unsigned char)((d2 >> 8) & 0xff); dp[6 * (size_t)seq] = (unsigned char)((d2 >> 16) & 0xff); dp[7 * (size_t)seq] = (unsigned char)(d2 >> 24); }
    }
}

#define XB_TMO      128
#define XB_XCNT(j)  (256  + 64 * (j))
#define XB_XSUB(j)  (1280 + 64 * (j))
#define XB_XGEN(j)  (2304 + 64 * (j))
#define XB_TOP      3328
#define XB_TOPGEN   3392
#define XCD_BAR_WORDS 3456
#define XB_SPIN_CAP (1u << 20)
__device__ __forceinline__ unsigned xb_ld(unsigned* p)              { return __hip_atomic_load(p, __ATOMIC_RELAXED, __HIP_MEMORY_SCOPE_AGENT); }
__device__ __forceinline__ unsigned xb_add(unsigned* p, unsigned v) { return __hip_atomic_fetch_add(p, v, __ATOMIC_RELAXED, __HIP_MEMORY_SCOPE_AGENT); }
__device__ __forceinline__ unsigned xb_xcc_id() { return (unsigned)__builtin_amdgcn_s_getreg((3 << 11) | 20) & 0xFu; }
#define XB_SPIN(cond, bar) do { unsigned _sp = 0; while (cond) { __builtin_amdgcn_s_sleep(1); \
    if ((++_sp & 255u) == 0u) { if (xb_ld(&(bar)[XB_TMO])) break; if (_sp > XB_SPIN_CAP) { atomicAdd(&(bar)[XB_TMO], 1u); break; } } } } while (0)
struct XcdBarrier { unsigned* bar; unsigned x; volatile LAS unsigned* st; };
__device__ __forceinline__ XcdBarrier xcd_barrier_post(unsigned* bar, volatile LAS unsigned* st) {
    XcdBarrier b; b.bar = bar; b.x = xb_xcc_id(); b.st = st;
    if (threadIdx.x == 0) (void)xb_add(&bar[XB_XCNT(b.x)], 1u);
    return b;
}
__device__ __forceinline__ void xcd_barrier_complete(unsigned* bar, unsigned x, unsigned& nloc, unsigned& nx) {
    const unsigned G = gridDim.x * gridDim.y * gridDim.z;
    unsigned sum, cnt, mine, sp = 0u;
    for (;;) {
        sum = 0u; cnt = 0u; mine = 0u;
#pragma unroll
        for (unsigned j = 0; j < 16; ++j) { const unsigned c = xb_ld(&bar[XB_XCNT(j)]); sum += c; cnt += (c > 0u) ? 1u : 0u; mine = (j == x) ? c : mine; }
        if (sum == G) break;
        __builtin_amdgcn_s_sleep(1);
        if ((++sp & 255u) == 0u) { if (xb_ld(&bar[XB_TMO])) break; if (sp > XB_SPIN_CAP) { atomicAdd(&bar[XB_TMO], 1u); break; } }
    }
    nloc = mine > 0u ? mine : 1u; nx = cnt > 0u ? cnt : 1u;
}
__device__ __forceinline__ void xcd_barrier(const XcdBarrier& b) {
    asm volatile("s_waitcnt vmcnt(0)" ::: "memory");
    __syncthreads();
    if (threadIdx.x == 0) {
        unsigned* bar = b.bar;
        __builtin_amdgcn_s_waitcnt(0);
        unsigned nloc = b.st[0], nx = b.st[1];
        if (nloc == 0u) { xcd_barrier_complete(bar, b.x, nloc, nx); b.st[0] = nloc; b.st[1] = nx; }
        const unsigned old = xb_add(&bar[XB_XSUB(b.x)], 1u);
        const unsigned gen = old / nloc;
        if (old + 1u == (gen + 1u) * nloc) {
            __builtin_amdgcn_fence(__ATOMIC_RELEASE, "agent");
            asm volatile("s_waitcnt vmcnt(0)" ::: "memory");
            const unsigned og = xb_add(&bar[XB_TOP], 1u);
            const unsigned tg = og / nx;
            if (og + 1u == (tg + 1u) * nx) xb_add(&bar[XB_TOPGEN], 1u);
            else XB_SPIN(xb_ld(&bar[XB_TOPGEN]) == tg, bar);
            __builtin_amdgcn_fence(__ATOMIC_ACQUIRE, "agent");
            xb_add(&bar[XB_XGEN(b.x)], 1u);
            asm volatile("s_waitcnt vmcnt(0)" ::: "memory");
        } else {
            XB_SPIN(xb_ld(&bar[XB_XGEN(b.x)]) == gen, bar);
            __builtin_amdgcn_fence(__ATOMIC_ACQUIRE, "agent");
            asm volatile("s_waitcnt vmcnt(0)" ::: "memory");
        }
    }
    __syncthreads();
}
constexpr size_t WS_BAR = 655360;
constexpr int LDS_MISC_OFF = 131072 + 2048;
static_assert(WS_BAR >= 3 * (size_t)NTOK * 4 && WS_BAR + XCD_BAR_WORDS * 4 <= WS_WIN && LDS_MISC_OFF + 16 <= LDS_BYTES, "barrier words");
#define AS4 __attribute__((address_space(4)))
#define PP const AS4 Args* ap = (const AS4 Args*)__builtin_amdgcn_kernarg_segment_ptr(); asm volatile("" : "+s"(ap)); \
    int tid_o = threadIdx.x; asm volatile("" : "+v"(tid_o)); const int tid = tid_o, lane = tid & 63; (void)tid; (void)lane; \
    unsigned char* ws = ap->ws; float* out = ap->out; (void)out; \
    float* ss1 = (float*)(ws + WS_SS); float* ss2 = ss1 + NTOK; float* ss3 = ss2 + NTOK; (void)ss1; (void)ss2; (void)ss3; \
    bf16_t* Win_t = (bf16_t*)(ws + WS_WIN); bf16_t* Wpa_t = (bf16_t*)(ws + WS_WPA); bf16_t* Wpb_t = (bf16_t*)(ws + WS_WPB); bf16_t* Wo_t = (bf16_t*)(ws + WS_WO); \
    bf16_t* Wcq_t = (bf16_t*)(ws + WS_WCQ); bf16_t* Wckv_t = (bf16_t*)(ws + WS_WCKV); bf16_t* Wco_t = (bf16_t*)(ws + WS_WCO); \
    bf16_t* Wup_t = (bf16_t*)(ws + WS_WUP); bf16_t* Wdn_t = (bf16_t*)(ws + WS_WDN); \
    bf16_t* memn = (bf16_t*)(ws + WS_MEMN); bf16_t* memkv = (bf16_t*)(ws + WS_MEMKV); \
    bf16_t* XB = (bf16_t*)(ws + WS_XB); bf16_t* QC = (bf16_t*)(ws + WS_QC); bf16_t* Z = (bf16_t*)(ws + WS_Z); bf16_t* HB = (bf16_t*)(ws + WS_Z); unsigned char* XN8 = ws + WS_XN8; unsigned char* Win8 = ws + WS_WIN; (void)XN8; (void)Win8; \
    unsigned char* Q8 = ws + WS_QC; unsigned char* K8 = ws + WS_QC + 32 * MiB; unsigned char* VT8 = ws + WS_QC + 40 * MiB; (void)Q8; (void)K8; (void)VT8; \
    unsigned char* O8A = ws + WS_O8A; unsigned char* O8B = ws + WS_O8B; unsigned char* M8 = (unsigned char*)(Z + Z_NAK); (void)O8A; (void)O8B; (void)M8; \
    (void)Win_t; (void)Wpa_t; (void)Wpb_t; (void)Wo_t; (void)Wcq_t; (void)Wckv_t; (void)Wco_t; (void)Wup_t; (void)Wdn_t; (void)memn; (void)memkv; (void)XB; (void)QC; (void)Z; (void)HB;
__global__ void __launch_bounds__(NWAVES * 64, 2) mega_fwd(Args args) {
    extern __shared__ __attribute__((aligned(16))) unsigned char lds[];
    LAS unsigned char* L = (LAS unsigned char*)lds;
    cg::grid_group grid = cg::this_grid();
    const int tid = threadIdx.x, lane = tid & 63, wave = __builtin_amdgcn_readfirstlane(tid >> 6);
    const int G = gridDim.x, bx = blockIdx.x;
    const int vcu = (G % 8 == 0) ? (bx % 8) * (G / 8) + bx / 8 : bx;
    const int gw = vcu * NWAVES + wave, NGW = G * NWAVES;
    const int lo = args.ph_lo, hi = args.ph_hi; int ph = 0;
    volatile LAS unsigned* bst = (volatile LAS unsigned*)(L + LDS_MISC_OFF);
    if (threadIdx.x < 4) bst[threadIdx.x] = 0u;
    __syncthreads();
    XcdBarrier xbar; xbar.bar = (unsigned*)(args.ws + WS_BAR); xbar.x = 0; xbar.st = bst;
    if (hi - lo > 1) xbar = xcd_barrier_post((unsigned*)(args.ws + WS_BAR), bst);
#ifndef PH_MASK
#define PH_MASK 0xffff
#endif
#ifndef DUP_P0
#define DUP_P0 0
#endif
#ifndef DUP_A
#define DUP_A 0
#endif
#ifndef DUP_GQA
#define DUP_GQA 0
#endif
#ifndef DUP_NA
#define DUP_NA 0
#endif
#ifndef DUP_I
#define DUP_I 0
#endif
#ifndef DUP_SYNC
#define DUP_SYNC 0
#endif
#ifndef DUP_G
#define DUP_G 0
#endif
#ifndef DUP_F
#define DUP_F 0
#endif
#define PHON(b) ((PH_MASK >> (b)) & 1)
#define RUN() (ph >= lo && ph < hi)
#define SEAM() do { if (ph >= lo && ph + 1 < hi) { if (ph == 0) grid.sync(); else xcd_barrier(xbar); for (int r_ = 0; r_ < DUP_SYNC; ++r_) xcd_barrier(xbar); } ++ph; } while (0)

    if (PHON(0) && RUN()) { PP
      _Pragma("unroll 1") for (int rep = 0; rep <= DUP_P0; ++rep) {
        for (int i = gw * 64 + lane; i < 3 * NTOK; i += NGW * 64) ss1[i] = 0.f;
        LAS float* scr = (LAS float*)(L + wave * 16384);
        constexpr int I_IN = (DM / 64) * (DIN / 32), I_PA = (1024 / 64) * (DM / 32), I_O = (DM / 64) * (DM / 32), I_CQ = (DM / 64) * (CWID / 32), I_CKV = (DM / 64) * (1024 / 32),
                      I_CO = (CWID / 64) * (DM / 32), I_UP = (DM / 64) * (DFF / 32), I_DN = (DFF / 64) * (DM / 32);
        constexpr int NITEMS = I_IN + 2 * I_PA + I_O + I_CQ + I_CKV + I_CO + I_UP + I_DN;
        for (int it = gw; it < NITEMS; it += NGW) {
            int r = it;
            if (r < I_IN) { transpose_item_fp8(ap->in[5], DM, DIN, Win8, ap->in[4], (float)(1 << W8_SHIFT), scr, r, lane); continue; } r -= I_IN;
            if (r < I_PA) { transpose_item_fp8(ap->in[9], 1024, DM, (unsigned char*)Wpa_t, nullptr, (float)(1 << W8_SHIFT), scr, r, lane); continue; } r -= I_PA;
            if (r < I_PA) { transpose_item_fp8(ap->in[10], 1024, DM, (unsigned char*)Wpb_t, nullptr, (float)(1 << W8_SHIFT), scr, r, lane); continue; } r -= I_PA;
            if (r < I_O) { transpose_item_fp8(ap->in[11], DM, DM, (unsigned char*)Wo_t, nullptr, (float)(1 << W8_SHIFT), scr, r, lane); continue; } r -= I_O;
            if (r < I_CQ) { transpose_item(ap->in[14], DM, CWID, Wcq_t, ap->in[12], scr, r, lane); continue; } r -= I_CQ;
            if (r < I_CKV) { transpose_item(ap->in[15], DM, 1024, Wckv_t, ap->in[13], scr, r, lane); continue; } r -= I_CKV;
            if (r < I_CO) { transpose_item(ap->in[16], CWID, DM, Wco_t, nullptr, scr, r, lane); continue; } r -= I_CO;
            if (r < I_UP) { transpose_item(ap->in[18], DM, DFF, Wup_t, ap->in[17], scr, r, lane); continue; } r -= I_UP;
            transpose_item(ap->in[19], DFF, DM, Wdn_t, nullptr, scr, r, lane);
        }
        for (int m = gw; m < NTOK; m += 2 * NGW) {
            const int m2 = m + NGW; const float* xa = (m < 32768) ? ap->in[0] + (size_t)m * DM : ap->in[1] + (size_t)(m - 32768) * DM;
            if (m2 < NTOK) { const float* xb2 = (m2 < 32768) ? ap->in[0] + (size_t)m2 * DM : ap->in[1] + (size_t)(m2 - 32768) * DM; rms_row2_to_fp8(xa, xb2, XN8 + (size_t)m * DM, XN8 + (size_t)m2 * DM, lane); }
            else rms_row_to_fp8(xa, XN8 + (size_t)m * DM, lane); }
        for (int m = gw; m < NMEMROWS; m += NGW) { const float* xr = (m < 1024) ? ap->in[2] + (size_t)m * DM : ap->in[3] + (size_t)(m - 1024) * DM; rms_row_to_bf16(xr, memn + (size_t)m * DM, lane); }
      }
    }
    SEAM();

#pragma unroll 1
    for (int c = 0; c < NCH; ++c) {
        const int row0 = c * 32768, CR = (c == 0) ? 32768 : 16384, nb = (c == 0) ? 4 : 1, seq = (c == 0) ? 8192 : 16384;
        if (PHON(1) && RUN()) { PP
            pg8::Gemm g{(const bf16_t*)(XN8 + (size_t)row0 * DM), (const bf16_t*)Win8, CR, DIN, DM / 2, DM / 2, 0}; pg8::StaticOrder S; S.init(CR, DIN, G, bx);
            pg8::EpiB E{Z, 0, 1, nullptr, 0};
            _Pragma("unroll 1") for (int rep = 0; rep <= DUP_A; ++rep)
            pg8::gemm_phase<pg8::EpiB, pg8::StaticOrder, true>(L, g, S, E);
        }
        SEAM();
        if (PHON(2) && RUN()) { PP
            rope_pass(Z + Z_GQ, Q8, 1024, CR, seq, ap->in[7], att::QPRE, gw, NGW, lane);
            rope_pass(Z + Z_GK, K8, 256, CR, seq, ap->in[8], 1.0f, gw, NGW, lane);
            vt_pass(Z + Z_GV, VT8, CR, seq, gw, NGW, lane);
        }
        SEAM();
        if (PHON(3) && RUN()) { PP
            const int nqb = seq / 256, NU = nb * 8 * nqb, nper = (NU + G - 1) / G;
            att::NaCtx na0{0, 0, 0, 0, 0, nullptr};
            bf16_t* DUMMY = (bf16_t*)(ws + 981 * MiB); (void)DUMMY;
            _Pragma("unroll 1") for (int rep = 0; rep <= DUP_GQA; ++rep)
            for (int i = 0; i < nper; ++i) { const int u = vcu * nper + i; if (u >= NU) break;
                const int qb = u % nqb; int t = u / nqb; const int gq = t % 4; t /= 4; const int kvh = t % 2, b = t / 2, h = kvh * 4 + gq;
                const size_t qoff = ((size_t)b * seq + (size_t)qb * 256) * 1024 + h * 128;
                att::attn_body_f8<1024, 256, 1024, OB_SHIFT>(Q8 + qoff, K8 + (size_t)b * seq * 256 + kvh * 128, VT8 + ((size_t)(b * 2 + kvh) * 128) * (size_t)seq, (long)seq, O8B + qoff, seq, (char*)lds);
            }
            __syncthreads();
            const int rows = seq / 64;
            _Pragma("unroll 1") for (int rep = 0; rep <= DUP_NA; ++rep)
            for (int i = 0; i < nper; ++i) { const int u = vcu * nper + i; if (u >= NU) break;
                const int h = u % 8; int t = u / 8; const int rg = t % nqb, b = t / nqb, R0 = 4 * rg;
                int kr0 = R0 - 4; kr0 = kr0 < 0 ? 0 : (kr0 > rows - 12 ? rows - 12 : kr0);
                LAS float* tb = (LAS float*)(L + att::NA_TBL_OFF) + att::NA_TBL_PAD;
                if (tid < 15 * 32) { const int dr = tid >> 5, dc = tid & 31; tb[tid] = (dc < 31) ? ap->in[6][(h * 15 + dr) * 31 + dc] * (1.0f / att::SCALE) : 0.f; }
                att::NaCtx na; na.r = R0 + (wave >> 1); na.rs = na.r - 4 < 0 ? 0 : (na.r - 4 > rows - 8 ? rows - 8 : na.r - 4);
                na.c = (wave & 1) * 32 + (lane & 31); na.cs = na.c - 8 < 0 ? 0 : (na.c - 8 > 48 ? 48 : na.c - 8); na.kr0 = kr0; na.tbl = tb;
                bf16_t* Q = Z + Z_NAQ + ((size_t)b * seq + (size_t)R0 * 64) * 1024 + h * 128;
                const bf16_t* Kp = Z + Z_NAK + ((size_t)b * seq + (size_t)kr0 * 64) * 1024 + h * 128; const bf16_t* Vp = Z + Z_NAV + ((size_t)b * seq + (size_t)kr0 * 64) * 1024 + h * 128;
                att::attn_body<1024, 1024, 1024, true, OA_SHIFT>(Q, Kp, Vp, (bf16_t*)(O8A + ((size_t)b * seq + (size_t)R0 * 64) * 1024 + h * 128), 12 * 64, (char*)lds, na);
            }
            __syncthreads();
        }
        SEAM();
        if (PHON(4) && RUN()) { PP
            { pg8::Gemm g{(const bf16_t*)O8A, Wpa_t, CR, DM, 512, 512, OA_SHIFT}; pg8::StaticOrder S; S.init(CR, DM, G, bx);
              pg8::EpiGate E{Z + Z_GA, Z + Z_GA, nullptr, 0}; pg8::gemm_phase<pg8::EpiGate, pg8::StaticOrder, true>(L, g, S, E); }
            { pg8::Gemm g{(const bf16_t*)O8B, Wpb_t, CR, DM, 512, 512, OB_SHIFT}; pg8::StaticOrder S; S.init(CR, DM, G, bx);
              pg8::EpiGate E{Z + Z_GB, Z + Z_GA, M8, 1}; pg8::gemm_phase<pg8::EpiGate, pg8::StaticOrder, true>(L, g, S, E); }
        }
        SEAM();
        if (PHON(5) && RUN()) { PP
            const float* xin = (c == 0) ? ap->in[0] : ap->in[1];
            pg8::Gemm g{(const bf16_t*)M8, Wo_t, CR, DM, DM / 2, DM / 2, MX_SHIFT}; pg8::StaticOrder S; S.init(CR, DM, G, bx);
            pg8::EpiRes<true> E{xin, nullptr, XB + (size_t)row0 * DM, ss1 + row0};
            pg8::gemm_phase<pg8::EpiRes<true>, pg8::StaticOrder, true>(L, g, S, E);
        }
        SEAM();
    }
    if (PHON(6) && RUN()) { PP
        { pg8::Gemm g{XB, Wcq_t, NTOK, CWID, DM, DM, 0}; pg8::StaticOrder S; S.init(NTOK, CWID, G, bx);
          pg8::EpiB E{QC, CWID, 0, ss1, 0};
          _Pragma("unroll 1") for (int rep = 0; rep <= DUP_F; ++rep)
          pg8::gemm_phase<pg8::EpiB, pg8::StaticOrder>(L, g, S, E); }
        { pg8::Gemm g{memn, Wckv_t, NMEMROWS, 1024, DM, DM, 0}; pg8::StaticOrder S; S.init(NMEMROWS, 1024, G, (bx + G / 2) % G);
          pg8::EpiB E{memkv, 1024, 0, nullptr, 0}; pg8::gemm_phase<pg8::EpiB, pg8::StaticOrder>(L, g, S, E); }
    }
    SEAM();
    if (PHON(7) && RUN()) { PP
        const int NU = (NTOK / 256) * 4, nper = (NU + G - 1) / G;
        att::NaCtx na0{0, 0, 0, 0, 0, nullptr};
        bf16_t* DUMMY = (bf16_t*)(ws + 981 * MiB); (void)DUMMY;
        _Pragma("unroll 1") for (int rep = 0; rep <= DUP_G; ++rep)
        for (int i = 0; i < nper; ++i) { const int u = vcu * nper + i; if (u >= NU) break;
            const int h = u % 4, rb = u / 4, b = (rb < 128) ? (rb >> 5) : 4;
            bf16_t* Q = QC + (size_t)rb * 256 * CWID + h * 128;
            const bf16_t* Kp = memkv + (size_t)b * 256 * 1024 + h * 128; const bf16_t* Vp = Kp + 512;
            att::attn_body<512, 1024, 512, false>(Q, Kp, Vp, (rep < DUP_G) ? DUMMY + (Q - QC) : Q, 256, (char*)lds, na0);
        }
        __syncthreads();
    }
    SEAM();
    if (PHON(8) && RUN()) { PP
        pg8::Gemm g{QC, Wco_t, NTOK, DM, CWID, CWID, 0}; pg8::StaticOrder S; S.init(NTOK, DM, G, bx);
        pg8::EpiRes<false> E{nullptr, XB, XB, ss2}; pg8::gemm_phase<pg8::EpiRes<false>, pg8::StaticOrder>(L, g, S, E);
    }
    SEAM();
#pragma unroll 1
    for (int c = 0; c < NCH; ++c) {
        const int row0 = c * 32768, CR = (c == 0) ? 32768 : 16384;
        if (PHON(9) && RUN()) { PP
            pg8::Gemm g{XB + (size_t)row0 * DM, Wup_t, CR, DFF, DM, DM, 0}; pg8::StaticOrder S; S.init(CR, DFF, G, bx);
            pg8::EpiB E{HB, DFF, 0, ss2 + row0, 1};
            _Pragma("unroll 1") for (int rep = 0; rep <= DUP_I; ++rep)
            pg8::gemm_phase<pg8::EpiB, pg8::StaticOrder>(L, g, S, E);
        }
        SEAM();
        if (PHON(10) && RUN()) { PP
            pg8::Gemm g{HB, Wdn_t, CR, DM, DFF, DFF, 0}; pg8::StaticOrder S; S.init(CR, DM, G, bx);
            pg8::EpiRes<false> E{nullptr, XB + (size_t)row0 * DM, XB + (size_t)row0 * DM, ss3 + row0}; pg8::gemm_phase<pg8::EpiRes<false>, pg8::StaticOrder>(L, g, S, E);
        }
        SEAM();
    }
    if (PHON(11) && RUN()) { PP
        const float* gf = ap->in[20];
        f32x4 gv[8];
#pragma unroll
        for (int j = 0; j < 8; ++j) gv[j] = *((const f32x4*)gf + lane + 64 * j);
        for (int m = gw; m < NTOK; m += NGW) { const float rr = __builtin_amdgcn_rsqf(ss3[m] * (1.f / DM) + EPS);
            const u32x2* xb = (const u32x2*)(XB + (size_t)m * DM) + lane; f32x4* xr = (f32x4*)(out + (size_t)m * DM) + lane;
            u32x2 r[8];
#pragma unroll
            for (int j = 0; j < 8; ++j) r[j] = xb[64 * j];
#pragma unroll
            for (int j = 0; j < 8; ++j) { f32x4 v = (f32x4){bf_lo(r[j].x), bf_hi(r[j].x), bf_lo(r[j].y), bf_hi(r[j].y)}; v = v * rr * gv[j]; xr[64 * j] = v; } }
    }
#undef RUN
#undef SEAM
}

extern "C" void kernel_launch(void* const* d_in, const int* in_sizes, int n_in, void* d_out, int out_size, void* d_ws, size_t ws_size, hipStream_t stream) {
    static int grid = 0;
    if (grid == 0) {
        if (n_in != 21 || out_size != NTOK * DM || ws_size < WS_END) { fprintf(stderr, "kernel_launch: unexpected shapes n_in %d out %d ws %zu\n", n_in, out_size, ws_size); grid = -1; return; }
        int dev = 0, cus = 0, per_cu = 0;
        if (hipGetDevice(&dev) != hipSuccess || hipDeviceGetAttribute(&cus, hipDeviceAttributeMultiprocessorCount, dev) != hipSuccess) { grid = -1; return; }
        if (hipFuncSetAttribute((const void*)mega_fwd, hipFuncAttributeMaxDynamicSharedMemorySize, LDS_BYTES) != hipSuccess) { fprintf(stderr, "kernel_launch: hipFuncSetAttribute failed\n"); grid = -1; return; }
        if (hipOccupancyMaxActiveBlocksPerMultiprocessor(&per_cu, (const void*)mega_fwd, NWAVES * 64, LDS_BYTES) != hipSuccess || per_cu < 1) per_cu = 1;
        (void)hipGetLastError();
        grid = cus * 1;
        (void)per_cu;
    }
    if (grid < 0) return;
    Args a{};
    for (int i = 0; i < 21; ++i) a.in[i] = (const float*)d_in[i];
    a.out = (float*)d_out; a.ws = (unsigned char*)d_ws;
#if MK_MULTI
    for (int p = 0; p < NPH; ++p) { a.ph_lo = p; a.ph_hi = p + 1; hipLaunchKernelGGL(mega_fwd, dim3(grid), dim3(NWAVES * 64), LDS_BYTES, stream, a); }
#else
    a.ph_lo = 0; a.ph_hi = NPH;
    if (hipMemsetAsync((char*)d_ws + WS_BAR, 0, XCD_BAR_WORDS * 4, stream) != hipSuccess) { fprintf(stderr, "kernel_launch: memset of barrier words failed\n"); return; }
    void* kargs[] = {&a};
    hipError_t e = hipLaunchCooperativeKernel((const void*)mega_fwd, dim3(grid), dim3(NWAVES * 64), kargs, LDS_BYTES, stream);
    if (e != hipSuccess) fprintf(stderr, "cooperative launch failed: %s (grid %d)\n", hipGetErrorString(e), grid);
#endif
}
```

```cpp
#include <hip/hip_runtime.h>
#include <hip/hip_bf16.h>
#include <hip/hip_cooperative_groups.h>
#include <cstdio>
#include <cstdint>
#include <cmath>
#include <type_traits>
namespace cg = cooperative_groups;

#ifndef MK_MULTI
#define MK_MULTI 0
#endif

#define LAS __attribute__((address_space(3)))
typedef unsigned short bf16_t;
typedef short bf16x8 __attribute__((ext_vector_type(8)));
typedef short s16x4 __attribute__((ext_vector_type(4)));
typedef float f32x2 __attribute__((ext_vector_type(2)));
typedef float f32x4 __attribute__((ext_vector_type(4)));
typedef float f32x16 __attribute__((ext_vector_type(16)));
typedef unsigned u32x2 __attribute__((ext_vector_type(2)));
typedef unsigned u32x4 __attribute__((ext_vector_type(4)));
typedef int i32x4 __attribute__((ext_vector_type(4)));
typedef int i32x8 __attribute__((ext_vector_type(8)));

constexpr int DM = 2048, NTOK = 49152, CH = 32768  , NCH = 2, DIN = 8704, DFF = 8192, NMEMROWS = 1280, CWID = 512;
constexpr float EPS = 1e-6f;
constexpr size_t MiB = 1u << 20;
constexpr size_t WS_SS = 0;
constexpr size_t WS_WIN = 1 * MiB, WS_WPA = 35 * MiB, WS_WPB = 39 * MiB, WS_WO = 43 * MiB, WS_WCQ = 51 * MiB, WS_WCKV = 53 * MiB,
                 WS_WCO = 57 * MiB, WS_WUP = 59 * MiB, WS_WDN = 91 * MiB, WS_MEMN = 123 * MiB, WS_MEMKV = 128 * MiB, WS_XB = 131 * MiB,
                 WS_QC = 323 * MiB, WS_Z = 371 * MiB, WS_ZEND = 915 * MiB, WS_XN8 = WS_XB + 96 * MiB  , WS_O8A = 916 * MiB, WS_O8B = 948 * MiB  , WS_END = 980 * MiB;
constexpr size_t Z_NAQ = 0, Z_NAK = (size_t)CH * 1024, Z_NAV = (size_t)2 * CH * 1024, Z_GQ = (size_t)3 * CH * 1024, Z_GK = (size_t)4 * CH * 1024,
                 Z_GV = Z_GK + (size_t)CH * 256, Z_GA = Z_GV + (size_t)CH * 256, Z_GB = Z_GA + (size_t)CH * 2048;
static_assert((Z_GB + (size_t)CH * 2048) * 2 <= WS_ZEND - WS_Z, "z region");
static_assert((size_t)CH * DFF * 2 <= WS_ZEND - WS_Z, "h overlay");
constexpr int W8_SHIFT = 5, OA_SHIFT = 4, OB_SHIFT = 5, MX_SHIFT = 4;

__device__ __forceinline__ unsigned cvt_pk_bf16(float lo, float hi) { unsigned r; asm volatile("v_cvt_pk_bf16_f32 %0, %1, %2" : "=v"(r) : "v"(lo), "v"(hi)); return r; }
__device__ __forceinline__ unsigned pack4_fp8(float a, float b, float c, float d) { int r = 0; r = __builtin_amdgcn_cvt_pk_fp8_f32(a, b, r, false); r = __builtin_amdgcn_cvt_pk_fp8_f32(c, d, r, true); return (unsigned)r; }
__device__ __forceinline__ float bf_lo(unsigned w) { return __uint_as_float(w << 16); }
__device__ __forceinline__ float bf_hi(unsigned w) { return __uint_as_float(w & 0xffff0000u); }
__device__ __forceinline__ float sigmoidf_(float x) { return __builtin_amdgcn_rcpf(1.0f + __builtin_amdgcn_exp2f(-1.4426950408889634f * x)); }

namespace pg8 {
constexpr int BM = 256, BK = 64, HALF = 128, HTB = HALF * BK * 2, STAGE_BYTES = 8 * HTB, NXCD = 8, WGM = 8;
__host__ __device__ __forceinline__ int lds_byte(int r, int c) { const int st = (r >> 4) * 2 + (c >> 5), rr = r & 15, cc = c & 31, ob = rr * 64 + cc * 2; return st * 1024 + (ob ^ (((ob >> 9) & 1) << 5)); }
__host__ __device__ __forceinline__ void stage_rc(int b, int& R, int& C) { const int st = b / 1024, sb = b % 1024, swz = sb ^ (((sb >> 9) & 1) << 5); R = (st >> 1) * 16 + swz / 64; C = (st & 1) * 32 + (swz % 64) / 2; }
__host__ __device__ __forceinline__ int perm32(int rho) { const int n = rho >> 4, i = rho & 15; return 8 * (i >> 2) + 4 * n + (i & 3); }
struct Unit { int pm, pn; };
struct Gemm { const bf16_t* A; const bf16_t* Bt; int M, N, K, lda; int xshift; };
struct StaticOrder {
    int nM, nN, nwg, G, c;
    __device__ void init(int M, int N, int G_, int c_) { nM = M / BM; nN = N / BM; nwg = nM * nN; G = G_; c = c_; }
    __device__ bool next(int i, Unit& u) const {
        const long L = (long)i * G + c; if (L >= nwg) return false;
        int wgid = (int)L; { const int q = nwg / NXCD, r = nwg % NXCD, xcd = wgid % NXCD, off = wgid / NXCD; wgid = (xcd < r ? xcd * (q + 1) : r * (q + 1) + (xcd - r) * q) + off; }
        const int nig = WGM * nN, gid = wgid / nig, fm = gid * WGM, gsz = (nM - fm) < WGM ? (nM - fm) : WGM;
        u.pm = fm + ((wgid % nig) % gsz); u.pn = (wgid % nig) / gsz; return true;
    }
};

struct EpiB {
    static constexpr bool PERM = true;
    bf16_t* O; int ldc; int route; const float* ss; int act;
    __device__ __forceinline__ void operator()(const f32x4 (&acc)[2][2][4][2], const Unit& u, int wr, int wc, int fr, int fq) const {
        const int row0 = u.pm * BM + wr * 64 + fr; bf16_t* base = O; int ld = ldc, colt = u.pn * BM;
        if (route) { const int pn = u.pn;
            if (pn < 16) { base += (size_t)(pn >> 2) * ((size_t)CH * 1024); ld = 1024; colt = (pn & 3) * 256; }
            else if (pn < 18) { base += Z_GK + (size_t)(pn - 16) * ((size_t)CH * 256); ld = 256; colt = 0; }
            else { base += Z_GA + (size_t)((pn - 18) >> 3) * ((size_t)CH * 2048); ld = 2048; colt = ((pn - 18) & 7) * 256; } }
        const int col0 = colt + wc * 32 + 8 * fq;
#pragma unroll
        for (int ai = 0; ai < 2; ++ai)
#pragma unroll
            for (int m = 0; m < 4; ++m) { const int row = row0 + ai * HALF + m * 16; float sc = 1.f;
                if (ss) sc = __builtin_amdgcn_rsqf(ss[row] * (1.0f / DM) + EPS);
                bf16_t* rowp = base + (size_t)row * ld + col0;
#pragma unroll
                for (int bj = 0; bj < 2; ++bj) { f32x4 v0 = acc[ai][bj][m][0] * sc, v1 = acc[ai][bj][m][1] * sc;
                    if (act) {
#pragma unroll
                        for (int e = 0; e < 4; ++e) { float a = fmaxf(v0[e], 0.f), b = fmaxf(v1[e], 0.f); v0[e] = a * a; v1[e] = b * b; } }
                    u32x4 w; w.x = cvt_pk_bf16(v0[0], v0[1]); w.y = cvt_pk_bf16(v0[2], v0[3]); w.z = cvt_pk_bf16(v1[0], v1[1]); w.w = cvt_pk_bf16(v1[2], v1[3]);
                    *(u32x4*)(rowp + bj * HALF) = w; } }
    }
};
struct EpiGate {
    static constexpr bool PERM = true;
    const bf16_t* G; bf16_t* T; unsigned char* M8; int second;
    __device__ __forceinline__ void ldgrp(u32x4 (&gg)[2], u32x4 (&tt)[2], size_t ro) const {
#pragma unroll
        for (int bj = 0; bj < 2; ++bj) { gg[bj] = *(const u32x4*)(G + ro + bj * HALF); if (second) tt[bj] = *(const u32x4*)(T + ro + bj * HALF); else tt[bj] = (u32x4){0u, 0u, 0u, 0u}; }
    }
    __device__ __forceinline__ void operator()(const f32x4 (&acc)[2][2][4][2], const Unit& u, int wr, int wc, int fr, int fq) const {
        const int row0 = u.pm * BM + wr * 64 + fr, col0 = u.pn * BM + wc * 32 + 8 * fq;
        u32x4 gg[2], tt[2], gn[2], tn[2];
        ldgrp(gg, tt, (size_t)row0 * 2048 + col0);
#pragma unroll
        for (int gi = 0; gi < 8; ++gi) { const int ai = gi >> 2, m = gi & 3; const size_t ro = (size_t)(row0 + ai * HALF + m * 16) * 2048 + col0;
            if (gi < 7) ldgrp(gn, tn, (size_t)(row0 + ((gi + 1) >> 2) * HALF + ((gi + 1) & 3) * 16) * 2048 + col0);
#pragma unroll
            for (int bj = 0; bj < 2; ++bj) { const u32x4 g = gg[bj];
                f32x4 v0 = acc[ai][bj][m][0], v1 = acc[ai][bj][m][1];
                v0[0] *= sigmoidf_(bf_lo(g.x)); v0[1] *= sigmoidf_(bf_hi(g.x)); v0[2] *= sigmoidf_(bf_lo(g.y)); v0[3] *= sigmoidf_(bf_hi(g.y));
                v1[0] *= sigmoidf_(bf_lo(g.z)); v1[1] *= sigmoidf_(bf_hi(g.z)); v1[2] *= sigmoidf_(bf_lo(g.w)); v1[3] *= sigmoidf_(bf_hi(g.w));
                if (second) { const u32x4 t = tt[bj];
                    v0[0] += bf_lo(t.x); v0[1] += bf_hi(t.x); v0[2] += bf_lo(t.y); v0[3] += bf_hi(t.y);
                    v1[0] += bf_lo(t.z); v1[1] += bf_hi(t.z); v1[2] += bf_lo(t.w); v1[3] += bf_hi(t.w);
                    constexpr float MS = (float)(1 << MX_SHIFT); v0 = v0 * MS; v1 = v1 * MS;
                    u32x2 w; w.x = pack4_fp8(v0[0], v0[1], v0[2], v0[3]); w.y = pack4_fp8(v1[0], v1[1], v1[2], v1[3]);
                    *(u32x2*)(M8 + ro + bj * HALF) = w; }
                else { u32x4 w; w.x = cvt_pk_bf16(v0[0], v0[1]); w.y = cvt_pk_bf16(v0[2], v0[3]); w.z = cvt_pk_bf16(v1[0], v1[1]); w.w = cvt_pk_bf16(v1[2], v1[3]);
                    *(u32x4*)(T + ro + bj * HALF) = w; } }
#pragma unroll
            for (int bj = 0; bj < 2; ++bj) { gg[bj] = gn[bj]; tt[bj] = tn[bj]; }
        }
    }
};
template <bool XF>
struct EpiRes {
    static constexpr bool PERM = false;
    const float* Xf; const bf16_t* Xb; bf16_t* XB; float* ss;
    typedef typename std::conditional<XF, f32x4, u32x2>::type raw_t;
    __device__ __forceinline__ void ldgrp(raw_t (&r)[2][2], size_t ro) const {
#pragma unroll
        for (int bj = 0; bj < 2; ++bj)
#pragma unroll
            for (int n = 0; n < 2; ++n) { const size_t off = ro + bj * HALF + n * 16;
                if constexpr (XF) r[bj][n] = *(const f32x4*)(Xf + off); else r[bj][n] = *(const u32x2*)(Xb + off); }
    }
    __device__ __forceinline__ void operator()(const f32x4 (&acc)[2][2][4][2], const Unit& u, int wr, int wc, int fr, int fq) const {
        const int row0 = u.pm * BM + wr * 64 + fr, col0 = u.pn * BM + wc * 32 + 4 * fq;
        raw_t cur[2][2], nxt[2][2];
        ldgrp(cur, (size_t)row0 * 2048 + col0);
#pragma unroll
        for (int g = 0; g < 8; ++g) { const int ai = g >> 2, m = g & 3;
            if (g < 7) ldgrp(nxt, (size_t)(row0 + ((g + 1) >> 2) * HALF + ((g + 1) & 3) * 16) * 2048 + col0);
            const int row = row0 + ai * HALF + m * 16; const size_t ro = (size_t)row * 2048 + col0; float s = 0.f;
#pragma unroll
            for (int bj = 0; bj < 2; ++bj)
#pragma unroll
                for (int n = 0; n < 2; ++n) { const size_t off = ro + bj * HALF + n * 16;
                    f32x4 x;
                    if constexpr (XF) x = cur[bj][n]; else x = (f32x4){bf_lo(cur[bj][n].x), bf_hi(cur[bj][n].x), bf_lo(cur[bj][n].y), bf_hi(cur[bj][n].y)};
                    const f32x4 v = x + acc[ai][bj][m][n];
                    s += (v[0] * v[0] + v[1] * v[1]) + (v[2] * v[2] + v[3] * v[3]);
                    u32x2 w; w.x = cvt_pk_bf16(v[0], v[1]); w.y = cvt_pk_bf16(v[2], v[3]); *(u32x2*)(XB + off) = w; }
            s += __shfl_xor(s, 16); s += __shfl_xor(s, 32);
            if (fq == 0) unsafeAtomicAdd(ss + row, s);
#pragma unroll
            for (int bj = 0; bj < 2; ++bj)
#pragma unroll
                for (int n = 0; n < 2; ++n) cur[bj][n] = nxt[bj][n];
        }
    }
};

template <class Epi, class Sched, bool FP8 = false>
__device__ __forceinline__ void gemm_phase(LAS unsigned char* lds, const Gemm g, const Sched& S, const Epi& E) {
    int tid_ = threadIdx.x; asm volatile("" : "+v"(tid_));
    const int tid = tid_, wid = __builtin_amdgcn_readfirstlane(tid >> 6), lane = tid & 63, wr = wid >> 2, wc = wid & 3, fr = lane & 15, fq = lane >> 4;
    const int K = g.K, nt = K / BK, lda = g.lda;
    unsigned voffA[2], voffB[2];
#pragma unroll
    for (int i = 0; i < 2; ++i) { int R, C; stage_rc(tid * 16 + i * 8192, R, C); const int Rb = Epi::PERM ? ((R & ~31) + perm32(R & 31)) : R;
        voffA[i] = (unsigned)(R * lda + C) * 2u; voffB[i] = (unsigned)(Rb * K + C) * 2u; }
    const size_t kstep = (size_t)(BK * 2);
    const size_t hstepA = (size_t)HALF * lda * 2, hstepB = (size_t)HALF * K * 2, tstepA = 2 * hstepA, tstepB = 2 * hstepB;
    const unsigned ldsw = (unsigned)wid * 1024u;
    const int aoff = lds_byte(wr * 64 + fr, fq * 8), boff = lds_byte(wc * 32 + fr, fq * 8);
#define PG8_SA(b, h) (((b) * 2 + (h)) * HTB)
#define PG8_SB(b, h) ((4 + (b) * 2 + (h)) * HTB)
#define PG8_STAGE(bufoff, gbase, voff) do { _Pragma("unroll") for (int _i = 0; _i < 2; ++_i) \
        __builtin_amdgcn_global_load_lds((const unsigned*)((const char*)(gbase) + (voff)[_i]), (LAS unsigned*)(lds + (bufoff) + ldsw + _i * 8192), 16, 0, 0); } while (0)
#define PG8_LD2(p) __builtin_shufflevector(*(const LAS i32x4*)(p), *(const LAS i32x4*)((p) + 1024), 0, 1, 2, 3, 4, 5, 6, 7)
#define PG8_LDA(dst, b, h) do { _Pragma("unroll") for (int m = 0; m < 4; ++m) dst[m] = PG8_LD2(lds + PG8_SA(b, h) + aoff + m * 2048); } while (0)
#define PG8_LDB(dst, b, h) do { _Pragma("unroll") for (int n = 0; n < 2; ++n) dst[n] = PG8_LD2(lds + PG8_SB(b, h) + boff + n * 2048); } while (0)
#define PG8_LO(x) __builtin_bit_cast(bf16x8, __builtin_shufflevector(x, x, 0, 1, 2, 3))
#define PG8_HI(x) __builtin_bit_cast(bf16x8, __builtin_shufflevector(x, x, 4, 5, 6, 7))
#define PG8_MMA(ai, bj, At, Bt) do { __builtin_amdgcn_s_setprio(1); _Pragma("unroll") for (int m = 0; m < 4; ++m) _Pragma("unroll") for (int n = 0; n < 2; ++n) { \
        if constexpr (FP8) asm volatile("v_mfma_scale_f32_16x16x128_f8f6f4 %0, %1, %2, %0, %3, %4 op_sel_hi:[0,0,0]" : "+v"(acc[ai][bj][m][n]) : "v"(Bt[n]), "v"(At[m]), "v"(scl_w), "v"(scl_x)); \
        else { acc[ai][bj][m][n] = __builtin_amdgcn_mfma_f32_16x16x32_bf16(PG8_LO(Bt[n]), PG8_LO(At[m]), acc[ai][bj][m][n], 0, 0, 0); \
               acc[ai][bj][m][n] = __builtin_amdgcn_mfma_f32_16x16x32_bf16(PG8_HI(Bt[n]), PG8_HI(At[m]), acc[ai][bj][m][n], 0, 0, 0); } } \
        __builtin_amdgcn_s_setprio(0); } while (0)
#define PG8_WAIT_V(n) asm volatile("s_waitcnt vmcnt(" #n ")" ::: "memory")
#define PG8_WAIT_L(n) asm volatile("s_waitcnt lgkmcnt(" #n ")" ::: "memory")
#define PG8_BAR __builtin_amdgcn_s_barrier()
#define PG8_SCHED __builtin_amdgcn_sched_barrier(0)
    Unit cur, nxt; int ui = 0;
    if (!S.next(0, cur)) return;
    f32x4 acc[2][2][4][2];
#pragma unroll
    for (int a = 0; a < 2; ++a)
#pragma unroll
        for (int b = 0; b < 2; ++b)
#pragma unroll
            for (int m = 0; m < 4; ++m)
#pragma unroll
                for (int n = 0; n < 2; ++n) acc[a][b][m][n] = (f32x4){0.f, 0.f, 0.f, 0.f};
    i32x8 At[4], B0[2], B1[2];
    int scl_w = 0x7f7f7f7f - W8_SHIFT * 0x01010101, scl_x = 0x7f7f7f7f - g.xshift * 0x01010101; asm volatile("" : "+v"(scl_w), "+v"(scl_x)); (void)scl_w; (void)scl_x;
    const char* cA = (const char*)g.A + (size_t)cur.pm * tstepA; const char* cB = (const char*)g.Bt + (size_t)cur.pn * tstepB;
    PG8_STAGE(PG8_SB(0, 0), cB, voffB); PG8_STAGE(PG8_SB(0, 1), cB + hstepB, voffB); PG8_STAGE(PG8_SA(0, 0), cA, voffA); PG8_STAGE(PG8_SA(0, 1), cA + hstepA, voffA);
    if (wr == 1) PG8_BAR;
    PG8_WAIT_V(2); PG8_BAR;
    PG8_STAGE(PG8_SB(1, 0), cB + kstep, voffB); PG8_STAGE(PG8_SA(1, 0), cA + kstep, voffA); PG8_STAGE(PG8_SB(1, 1), cB + hstepB + kstep, voffB);
    PG8_WAIT_V(6); PG8_BAR;
    for (;;) {
        const bool has_next = S.next(ui + 1, nxt);
        const char* nA = has_next ? (const char*)g.A + (size_t)nxt.pm * tstepA : cA; const char* nB = has_next ? (const char*)g.Bt + (size_t)nxt.pn * tstepB : cB;
        for (int t = 0; t < nt; t += 2) {
            const bool last = (t == nt - 2);
            const char* a1 = cA + (size_t)(t + 1) * kstep;
            const char* a2 = last ? nA : cA + (size_t)(t + 2) * kstep; const char* b2 = last ? nB : cB + (size_t)(t + 2) * kstep;
            const char* a3 = a2 + kstep; const char* b3 = b2 + kstep;
            PG8_LDB(B0, 0, 0); PG8_LDB(B1, 0, 1); PG8_SCHED; PG8_LDA(At, 0, 0); PG8_STAGE(PG8_SA(1, 1), a1 + hstepA, voffA);
            PG8_WAIT_V(8); PG8_WAIT_L(0); PG8_BAR; PG8_MMA(0, 0, At, B0); PG8_MMA(0, 1, At, B1); PG8_BAR; PG8_SCHED;
            PG8_LDA(At, 0, 1); PG8_STAGE(PG8_SB(0, 0), b2, voffB); PG8_STAGE(PG8_SB(0, 1), b2 + hstepB, voffB); PG8_STAGE(PG8_SA(0, 0), a2, voffA);
            PG8_WAIT_V(8); PG8_WAIT_L(0); PG8_BAR; PG8_MMA(1, 0, At, B0); PG8_MMA(1, 1, At, B1); PG8_BAR; PG8_SCHED;
            PG8_LDB(B0, 1, 0); PG8_LDB(B1, 1, 1); PG8_SCHED; PG8_LDA(At, 1, 0); PG8_STAGE(PG8_SA(0, 1), a2 + hstepA, voffA);
            PG8_WAIT_V(8); PG8_WAIT_L(0); PG8_BAR; PG8_MMA(0, 0, At, B0); PG8_MMA(0, 1, At, B1); PG8_BAR; PG8_SCHED;
            PG8_LDA(At, 1, 1); PG8_STAGE(PG8_SB(1, 0), b3, voffB); PG8_STAGE(PG8_SB(1, 1), b3 + hstepB, voffB); PG8_STAGE(PG8_SA(1, 0), a3, voffA);
            PG8_WAIT_V(8); PG8_WAIT_L(0); PG8_BAR; PG8_MMA(1, 0, At, B0); PG8_MMA(1, 1, At, B1); PG8_BAR; PG8_SCHED;
        }
        if (wr == 0) PG8_BAR;
        if constexpr (FP8) asm volatile("s_nop 15\n\ts_nop 15" ::: "memory");
        E(acc, cur, wr, wc, fr, fq);
        if (!has_next) break;
#pragma unroll
        for (int a = 0; a < 2; ++a)
#pragma unroll
            for (int b = 0; b < 2; ++b)
#pragma unroll
                for (int m = 0; m < 4; ++m)
#pragma unroll
                    for (int n = 0; n < 2; ++n) acc[a][b][m][n] = (f32x4){0.f, 0.f, 0.f, 0.f};
        cur = nxt; cA = nA; cB = nB; ++ui;
        if (wr == 1) PG8_BAR;
    }
    PG8_WAIT_V(0);
    PG8_BAR;
#undef PG8_SA
#undef PG8_SB
#undef PG8_STAGE
#undef PG8_LDA
#undef PG8_LDB
#undef PG8_MMA
#undef PG8_LD2
#undef PG8_LO
#undef PG8_HI
#undef PG8_WAIT_V
#undef PG8_WAIT_L
#undef PG8_BAR
#undef PG8_SCHED
}
}

namespace att {
constexpr int D = 128, NW = 8, QBLK = 32, KVBLK = 64;
constexpr float SCALE = 0.088388347648318440f;
constexpr int SHM_V = KVBLK * D * 2, SHM_K = KVBLK * D * 2, SHM_ATTN = 2 * SHM_V + 2 * SHM_K + NW * 64 * 4;
constexpr int NA_TBL_OFF = SHM_ATTN, NA_TBL_PAD = 48, NA_TBL_FLOATS = 48 + 15 * 32 + 96, ATT_LDS = NA_TBL_OFF + NA_TBL_FLOATS * 4;
#define KSWZ(row, colB) ((row) * 256 + ((colB) ^ (((row) & 7) << 4)))
#define SBAR() __builtin_amdgcn_sched_barrier(0)
__device__ __forceinline__ int crow(int r, int hi) { return (r & 3) + 8 * (r >> 2) + 4 * hi; }
__device__ __forceinline__ bf16x8 ld8(const bf16_t* p) { return *reinterpret_cast<const bf16x8*>(p); }

template <int THRV = 8>
__device__ __forceinline__ void partialSM(f32x16& p0, f32x16& p1, float& m_reg, float& mn, float& alpha) {
  constexpr float C = SCALE * 1.4426950408889634f; constexpr float THR = (float)THRV;
  float pmax = p0[0];
#pragma unroll
  for (int r = 1; r < 16; ++r) pmax = fmaxf(pmax, p0[r]);
#pragma unroll
  for (int r = 0; r < 16; ++r) pmax = fmaxf(pmax, p1[r]);
  { auto rr = __builtin_amdgcn_permlane32_swap(__float_as_uint(pmax), __float_as_uint(pmax), false, false);
    pmax = fmaxf(__uint_as_float(rr[0]), __uint_as_float(rr[1])); }
  if (__builtin_expect(__all(pmax - m_reg <= THR / SCALE), 1)) { mn = m_reg; alpha = 1.f; }
  else { mn = fmaxf(m_reg, pmax); alpha = __builtin_amdgcn_exp2f((m_reg - mn) * C); m_reg = mn; }
  float mnC = -mn * C;
#pragma unroll
  for (int r = 0; r < 16; ++r) p0[r] = fmaf(p0[r], C, mnC);
#pragma unroll
  for (int r = 0; r < 16; ++r) p1[r] = fmaf(p1[r], C, mnC);
#pragma unroll
  for (int r = 0; r < 16; ++r) p0[r] = __builtin_amdgcn_exp2f(p0[r]);
}
__device__ __forceinline__ void finishSM(f32x16& p0, f32x16& p1, float alpha, float& l_reg, bf16x8& pa0, bf16x8& pa1, bf16x8& pa2, bf16x8& pa3) {
#pragma unroll
  for (int r = 0; r < 16; ++r) p1[r] = __builtin_amdgcn_exp2f(p1[r]);
  float ps = 0;
#pragma unroll
  for (int r = 0; r < 16; ++r) ps += p0[r];
#pragma unroll
  for (int r = 0; r < 16; ++r) ps += p1[r];
  { auto rr = __builtin_amdgcn_permlane32_swap(__float_as_uint(ps), __float_as_uint(ps), false, false);
    ps = __uint_as_float(rr[0]) + __uint_as_float(rr[1]); }
  l_reg = l_reg * alpha + ps;
#define PK4(P, BASE, OUT) do { unsigned a0 = cvt_pk_bf16(P[BASE + 0], P[BASE + 1]), a1 = cvt_pk_bf16(P[BASE + 2], P[BASE + 3]);   \
    unsigned b0 = cvt_pk_bf16(P[BASE + 4], P[BASE + 5]), b1 = cvt_pk_bf16(P[BASE + 6], P[BASE + 7]);                              \
    auto r0 = __builtin_amdgcn_permlane32_swap(a0, b0, false, false); auto r1 = __builtin_amdgcn_permlane32_swap(a1, b1, false, false); \
    u32x4 w = {r0[0], r1[0], r0[1], r1[1]}; OUT = *reinterpret_cast<bf16x8*>(&w); } while (0)
  PK4(p0, 0, pa0); PK4(p0, 8, pa1); PK4(p1, 0, pa2); PK4(p1, 8, pa3);
#undef PK4
}
__device__ __forceinline__ void qkt(f32x16& p0, f32x16& p1, const bf16_t* Ks, const bf16x8* qr, int r32, int hi) {
  p0 = f32x16{}; p1 = f32x16{};
#pragma unroll
  for (int d0 = 0; d0 < 8; ++d0) { int cb = (d0 * 16 + hi * 8) * 2;
    bf16x8 b0 = *reinterpret_cast<const bf16x8*>((const char*)Ks + KSWZ(r32, cb));
    bf16x8 b1 = *reinterpret_cast<const bf16x8*>((const char*)Ks + KSWZ(32 + r32, cb));
    p0 = __builtin_amdgcn_mfma_f32_32x32x16_bf16(b0, qr[d0], p0, 0, 0, 0);
    p1 = __builtin_amdgcn_mfma_f32_32x32x16_bf16(b1, qr[d0], p1, 0, 0, 0); }
}
__device__ __forceinline__ int v_st(int k, int c) { const int kk = (k & ~0xC) | ((k & 4) << 1) | ((k & 8) >> 1); return ((kk >> 3) * 4 + (c >> 5)) * 512 + ((kk & 7) * 32 + (c & 31)) * 2; }
__device__ __forceinline__ int v_rd_base(int lane) { return ((lane & 3) << 3) | (((lane >> 2) & 3) << 6) | (((lane >> 4) & 1) << 5) | (((lane >> 5) & 1) << 8); }
constexpr int v_rd_off(int d0, int ks, int half) { return d0 * 512 + ks * 4096 + half * 2048; }
template <int OFF> __device__ __forceinline__ s16x4 tr_read(int vb) {
  s16x4 r; asm volatile("ds_read_b64_tr_b16 %0, %1 offset:%2" : "=&v"(r) : "v"(vb), "i"(OFF) : "memory"); return r;
}
template <int D0> __device__ __forceinline__ void pv_one(f32x16& od, int vb, bf16x8 pa0, bf16x8 pa1, bf16x8 pa2, bf16x8 pa3) {
  const s16x4 l0 = tr_read<v_rd_off(D0, 0, 0)>(vb), h0 = tr_read<v_rd_off(D0, 0, 1)>(vb), l1 = tr_read<v_rd_off(D0, 1, 0)>(vb), h1 = tr_read<v_rd_off(D0, 1, 1)>(vb);
  const s16x4 l2 = tr_read<v_rd_off(D0, 2, 0)>(vb), h2 = tr_read<v_rd_off(D0, 2, 1)>(vb), l3 = tr_read<v_rd_off(D0, 3, 0)>(vb), h3 = tr_read<v_rd_off(D0, 3, 1)>(vb);
  asm volatile("s_waitcnt lgkmcnt(0)" ::: "memory"); SBAR();
#define PK(L, H) (bf16x8){L[0], L[1], L[2], L[3], H[0], H[1], H[2], H[3]}
  od = __builtin_amdgcn_mfma_f32_32x32x16_bf16(pa0, PK(l0, h0), od, 0, 0, 0);
  od = __builtin_amdgcn_mfma_f32_32x32x16_bf16(pa1, PK(l1, h1), od, 0, 0, 0);
  od = __builtin_amdgcn_mfma_f32_32x32x16_bf16(pa2, PK(l2, h2), od, 0, 0, 0);
  od = __builtin_amdgcn_mfma_f32_32x32x16_bf16(pa3, PK(l3, h3), od, 0, 0, 0);
#undef PK
}
__device__ __forceinline__ void pv_d0(f32x16* o, int vb, bf16x8 pa0, bf16x8 pa1, bf16x8 pa2, bf16x8 pa3) {
  pv_one<0>(o[0], vb, pa0, pa1, pa2, pa3); pv_one<1>(o[1], vb, pa0, pa1, pa2, pa3); pv_one<2>(o[2], vb, pa0, pa1, pa2, pa3); pv_one<3>(o[3], vb, pa0, pa1, pa2, pa3);
}
struct NaCtx { int r, rs, c, cs, kr0; const LAS float* tbl; };
__device__ __forceinline__ void na_mask(f32x16& p0, f32x16& p1, const NaCtx& n, int tile, int hi) {
  const int kr = n.kr0 + tile; const bool vrow = (kr >= n.rs) && (kr < n.rs + 8);
  int dr = kr - n.r + 7; dr = dr < 0 ? 0 : (dr > 14 ? 14 : dr);
  const LAS float* t = n.tbl + dr * 32 + 15 - n.c;
  const float NEG = -INFINITY;
  const int d0 = 4 * hi - n.cs;
#pragma unroll
  for (int rr = 0; rr < 16; ++rr) { const int kq = (rr & 3) + 8 * (rr >> 2);
    const bool ok0 = vrow && ((unsigned)(kq + d0) < 16u), ok1 = vrow && ((unsigned)(kq + 32 + d0) < 16u);
    const float b0 = t[kq + 4 * hi], b1 = t[kq + 4 * hi + 32];
    p0[rr] = ok0 ? p0[rr] + b0 : NEG; p1[rr] = ok1 ? p1[rr] + b1 : NEG;
    if ((rr & 3) == 3) asm volatile("" ::: "memory"); }
}

template <int LDQ, int LDK, int LDO, bool NA, int OSH = -1>
__device__ __forceinline__ void attn_body(const bf16_t* Qb, const bf16_t* __restrict__ Kh, const bf16_t* __restrict__ Vh, bf16_t* Ob, int seq, char* lds, const NaCtx& na) {
  int tid_ = threadIdx.x; asm volatile("" : "+v"(tid_));
  const int tid = tid_, wid = tid >> 6, lane = tid & 63, r32 = lane & 31, hi = lane >> 5;
  bf16_t* V_lds = (bf16_t*)lds; bf16_t* K_lds = (bf16_t*)(lds + 2 * SHM_V);
  float* ws = (float*)(lds + 2 * SHM_V + 2 * SHM_K) + wid * 64; float* li_l = ws; float* al_l = ws + 32;
  float m_reg = -1e30f, l_reg = 0; f32x16 o[4] = {}; bf16x8 qr[8];
  const bf16_t* Qw = Qb + (long)(wid * QBLK + r32) * LDQ + hi * 8;
#pragma unroll
  for (int d0 = 0; d0 < 8; ++d0) qr[d0] = ld8(Qw + d0 * 16);
  const int sr = tid >> 4, sc = (tid & 15) * 8, vst0 = v_st(sr, sc), vst1 = v_st(32 + sr, sc);
  const int vb0 = (int)(uintptr_t)V_lds + v_rd_base(lane);
  struct { bf16x8 vs0, vs1, ks0, ks1; } sr_[2];
#define SLOAD(i, k0) do { sr_[i].vs0 = ld8(&Vh[(long)((k0) + sr) * LDK + sc]); sr_[i].vs1 = ld8(&Vh[(long)((k0) + 32 + sr) * LDK + sc]); \
    sr_[i].ks0 = ld8(&Kh[(long)((k0) + sr) * LDK + sc]); sr_[i].ks1 = ld8(&Kh[(long)((k0) + 32 + sr) * LDK + sc]); } while (0)
#define SWRITE(b, i) do { *(bf16x8*)((char*)V_lds + (b) * SHM_V + vst0) = sr_[i].vs0;          \
    *(bf16x8*)((char*)V_lds + (b) * SHM_V + vst1) = sr_[i].vs1; int kc = sc * 2;               \
    *(bf16x8*)((char*)K_lds + (b) * SHM_K + KSWZ(sr, kc)) = sr_[i].ks0;                       \
    *(bf16x8*)((char*)K_lds + (b) * SHM_K + KSWZ(32 + sr, kc)) = sr_[i].ks1; } while (0)
#define SWAIT() asm volatile("s_waitcnt vmcnt(4)" ::: "memory")
#define RESC(a) do { if (__any((a) < 1.f)) { if (hi == 0) al_l[r32] = (a); asm volatile("s_waitcnt lgkmcnt(0)" ::: "memory"); \
    _Pragma("unroll") for (int d = 0; d < 4; ++d) _Pragma("unroll") for (int r = 0; r < 16; ++r) o[d][r] *= al_l[crow(r, hi)]; } } while (0)
#define NAM(P0, P1, t) do { if constexpr (NA) { SBAR(); na_mask(P0, P1, na, (t), hi); SBAR(); } } while (0)
  f32x16 pA0, pA1, pB0, pB1; float mnA, mnB, alA, alB; bf16x8 pa0, pa1, pa2, pa3; const int NT = seq / KVBLK;
  constexpr int SE = 0, SO = 1;
  SLOAD(SE, 0); asm volatile("s_waitcnt vmcnt(0)" ::: "memory"); SWRITE(0, SE); __syncthreads();
  qkt(pA0, pA1, K_lds, qr, r32, hi); NAM(pA0, pA1, 0); partialSM(pA0, pA1, m_reg, mnA, alA);
  SLOAD(SO, KVBLK); if (2 < NT) SLOAD(SE, 2 * KVBLK);
  SWAIT(); SWRITE(1, SO); __syncthreads();
  for (int j = 1; j + 1 < NT; j += 2) {
    SBAR(); qkt(pB0, pB1, (bf16_t*)((char*)K_lds + SHM_K), qr, r32, hi);
    finishSM(pA0, pA1, alA, l_reg, pa0, pa1, pa2, pa3); SBAR();
    SLOAD(SO, (j + 2) * KVBLK); SBAR();
    pv_d0(o, vb0, pa0, pa1, pa2, pa3); NAM(pB0, pB1, j); partialSM(pB0, pB1, m_reg, mnB, alB);
    __syncthreads(); SWAIT(); SWRITE(0, SE);
    RESC(alB); __syncthreads();
    SBAR(); qkt(pA0, pA1, K_lds, qr, r32, hi);
    finishSM(pB0, pB1, alB, l_reg, pa0, pa1, pa2, pa3); SBAR();
    if (j + 3 < NT) SLOAD(SE, (j + 3) * KVBLK); SBAR();
    pv_d0(o, vb0 + (int)SHM_V, pa0, pa1, pa2, pa3); NAM(pA0, pA1, j + 1); partialSM(pA0, pA1, m_reg, mnA, alA);
    __syncthreads(); SWAIT(); SWRITE(1, SO);
    RESC(alA); __syncthreads();
  }
  SBAR(); qkt(pB0, pB1, (bf16_t*)((char*)K_lds + SHM_K), qr, r32, hi);
  finishSM(pA0, pA1, alA, l_reg, pa0, pa1, pa2, pa3); SBAR();
  pv_d0(o, vb0, pa0, pa1, pa2, pa3); NAM(pB0, pB1, NT - 1); partialSM(pB0, pB1, m_reg, mnB, alB);
  __syncthreads(); RESC(alB);
  finishSM(pB0, pB1, alB, l_reg, pa0, pa1, pa2, pa3); SBAR();
  pv_d0(o, vb0 + (int)SHM_V, pa0, pa1, pa2, pa3);
  if (hi == 0) li_l[r32] = l_reg; asm volatile("s_waitcnt lgkmcnt(0)" ::: "memory");
  float rli[16];
#pragma unroll
  for (int r = 0; r < 16; ++r) rli[r] = __builtin_amdgcn_rcpf(li_l[crow(r, hi)]);
  if constexpr (OSH >= 0) {
    unsigned char* Ow8 = (unsigned char*)Ob + (long)(wid * QBLK) * LDO;
#pragma unroll
    for (int r = 0; r < 16; ++r) { int orow = crow(r, hi); const float sc = rli[r] * (float)(1 << (OSH >= 0 ? OSH : 0));
#pragma unroll
      for (int d0 = 0; d0 < 4; ++d0) Ow8[(long)orow * LDO + d0 * 32 + r32] = (unsigned char)(__builtin_amdgcn_cvt_pk_fp8_f32(o[d0][r] * sc, 0.f, 0, false) & 0xff); }
  } else {
  bf16_t* Ow = Ob + (long)(wid * QBLK) * LDO;
#pragma unroll
  for (int r = 0; r < 16; ++r) { int orow = crow(r, hi);
#pragma unroll
    for (int d0 = 0; d0 < 4; ++d0) Ow[(long)orow * LDO + d0 * 32 + r32] = (bf16_t)(cvt_pk_bf16(o[d0][r] * rli[r], 0.f) & 0xffffu); }
  }
#undef SLOAD
#undef SWRITE
#undef SWAIT
#undef RESC
#undef NAM
}

__device__ __forceinline__ int vt_pos(int l) { const int kk = l & 31; return 32 * ((l >> 2) & 1) + (kk & 3) + 4 * (kk >> 3) + 16 * (l >> 5); }
#define F8_MFMA(A, B, C) __builtin_amdgcn_mfma_scale_f32_32x32x64_f8f6f4(A, B, C, 0, 0, 0, 0x7f7f7f7f, 0, 0x7f7f7f7f)
#define F8_MFMA_QK(A, B, C) __builtin_amdgcn_mfma_scale_f32_32x32x64_f8f6f4(A, B, C, 0, 0, 0, 0x7f7f7f7f, 0, 0x7c7c7c7c)
constexpr float QPRE = SCALE * 1.4426950408889634f * 8.0f;
template <int THRV>
__device__ __forceinline__ void partialSM8(f32x16& p0, f32x16& p1, float& m_reg, float& mn, float& alpha) {
  constexpr float THR2 = (float)THRV * 1.4426950408889634f;
  float pmax = p0[0];
#pragma unroll
  for (int r = 1; r < 16; ++r) pmax = fmaxf(pmax, p0[r]);
#pragma unroll
  for (int r = 0; r < 16; ++r) pmax = fmaxf(pmax, p1[r]);
  { auto rr = __builtin_amdgcn_permlane32_swap(__float_as_uint(pmax), __float_as_uint(pmax), false, false);
    pmax = fmaxf(__uint_as_float(rr[0]), __uint_as_float(rr[1])); }
  if (__builtin_expect(__all(pmax - m_reg <= THR2), 1)) { mn = m_reg; alpha = 1.f; }
  else { mn = fmaxf(m_reg, pmax); alpha = __builtin_amdgcn_exp2f(m_reg - mn); m_reg = mn; }
  p0 = p0 - mn; p1 = p1 - mn;
#pragma unroll
  for (int r = 0; r < 16; ++r) p0[r] = __builtin_amdgcn_exp2f(p0[r]);
}
#define F8_CAT(lo, hi) __builtin_shufflevector(lo, hi, 0, 1, 2, 3, 4, 5, 6, 7)
__device__ __forceinline__ void qkt8(f32x16& p0, f32x16& p1, const char* Ks, const i32x8* q8, int r32, int hi) {
  const int g = (r32 >> 1) & 7;
  const char* k0 = Ks + r32 * 128; const char* k1 = k0 + 32 * 128;
#pragma unroll
  for (int j = 0; j < 2; ++j) { const int c0 = 4 * j + 2 * hi;
    const i32x8 a0 = F8_CAT(*(const i32x4*)(k0 + (((c0) ^ g) << 4)), *(const i32x4*)(k0 + (((c0 + 1) ^ g) << 4)));
    const i32x8 a1 = F8_CAT(*(const i32x4*)(k1 + (((c0) ^ g) << 4)), *(const i32x4*)(k1 + (((c0 + 1) ^ g) << 4)));
    if (j == 0) { p0 = F8_MFMA_QK(a0, q8[0], f32x16{}); p1 = F8_MFMA_QK(a1, q8[0], f32x16{}); }
    else { p0 = F8_MFMA_QK(a0, q8[1], p0); p1 = F8_MFMA_QK(a1, q8[1], p1); } }
}
__device__ __forceinline__ void pv8(f32x16* o, const char* Vs, i32x8 pa, int r32, int hi) {
#pragma unroll
  for (int db = 0; db < 4; ++db) { const int d = 32 * db + r32, f = (d >> 2) & 3; const char* vr = Vs + d * 64;
    const i32x8 b = F8_CAT(*(const i32x4*)(vr + (((2 * hi) ^ f) << 4)), *(const i32x4*)(vr + (((2 * hi + 1) ^ f) << 4)));
    o[db] = F8_MFMA(pa, b, o[db]); }
}
__device__ __forceinline__ void finishSM8(f32x16& p0, f32x16& p1, float alpha, float& l_reg, i32x8& pa) {
#pragma unroll
  for (int r = 0; r < 16; ++r) p1[r] = __builtin_amdgcn_exp2f(p1[r]);
  float ps;
  { typedef float f32x8_ __attribute__((ext_vector_type(8)));
    const f32x16 t = p0 + p1;
    const f32x8_ t8 = __builtin_shufflevector(t, t, 0, 1, 2, 3, 4, 5, 6, 7) + __builtin_shufflevector(t, t, 8, 9, 10, 11, 12, 13, 14, 15);
    const f32x4 t4 = __builtin_shufflevector(t8, t8, 0, 1, 2, 3) + __builtin_shufflevector(t8, t8, 4, 5, 6, 7);
    const f32x2 t2 = __builtin_shufflevector(t4, t4, 0, 1) + __builtin_shufflevector(t4, t4, 2, 3);
    ps = t2.x + t2.y; }
  { auto rr = __builtin_amdgcn_permlane32_swap(__float_as_uint(ps), __float_as_uint(ps), false, false);
    ps = __uint_as_float(rr[0]) + __uint_as_float(rr[1]); }
  l_reg = l_reg * alpha + ps;
#pragma unroll
  for (int w = 0; w < 4; ++w) { pa[w] = (int)pack4_fp8(p0[4 * w], p0[4 * w + 1], p0[4 * w + 2], p0[4 * w + 3]); pa[4 + w] = (int)pack4_fp8(p1[4 * w], p1[4 * w + 1], p1[4 * w + 2], p1[4 * w + 3]); }
}
constexpr int F8_KB = 8192, F8_LDS_V = 2 * F8_KB, F8_LDS_WS = 4 * F8_KB;
template <int LDQ, int LDK, int LDO, int OSH>
__device__ __forceinline__ void attn_body_f8(const unsigned char* Qb, const unsigned char* __restrict__ Kh, const unsigned char* __restrict__ VTh, long ldv, unsigned char* Ob, int seq, char* lds) {
  int tid_ = threadIdx.x; asm volatile("" : "+v"(tid_));
  const int tid = tid_, wid = tid >> 6, lane = tid & 63, r32 = lane & 31, hi = lane >> 5;
  char* K_lds = lds; char* V_lds = lds + F8_LDS_V;
  float* ws = (float*)(lds + F8_LDS_WS) + wid * 64; float* li_l = ws; float* al_l = ws + 32;
  float m_reg = -1e30f, l_reg = 0; f32x16 o[4] = {}; i32x8 q8[2];
  { const unsigned char* Qw = Qb + (long)(wid * QBLK + r32) * LDQ + 32 * hi;
#pragma unroll
    for (int j = 0; j < 2; ++j) q8[j] = F8_CAT(*(const i32x4*)(Qw + 64 * j), *(const i32x4*)(Qw + 64 * j + 16)); }
  const int krow = tid >> 3, kc = tid & 7, kst = krow * 128 + ((kc ^ ((krow >> 1) & 7)) << 4);
  const int vd = tid >> 2, vc = tid & 3, vst = vd * 64 + ((vc ^ ((vd >> 2) & 3)) << 4);
  const unsigned char* kg = Kh + (long)krow * LDK + 16 * kc; const unsigned char* vg = VTh + (long)vd * ldv + 16 * vc;
  struct { i32x4 ks, vs; } sr_[2];
#define SLOAD(i, k0) do { sr_[i].ks = *(const i32x4*)(kg + (long)(k0) * LDK); sr_[i].vs = *(const i32x4*)(vg + (k0)); } while (0)
#define SWRITE(b, i) do { *(i32x4*)(K_lds + (b) * F8_KB + kst) = sr_[i].ks; *(i32x4*)(V_lds + (b) * F8_KB + vst) = sr_[i].vs; } while (0)
#define SWAIT() asm volatile("s_waitcnt vmcnt(2)" ::: "memory")
#define RESC(a) do { if (__any((a) < 1.f)) { if (hi == 0) al_l[r32] = (a); asm volatile("s_waitcnt lgkmcnt(0)" ::: "memory"); \
    _Pragma("unroll") for (int d = 0; d < 4; ++d) _Pragma("unroll") for (int r = 0; r < 16; ++r) o[d][r] *= al_l[crow(r, hi)]; } } while (0)
#define PV8(b, pa) do { asm volatile("s_waitcnt lgkmcnt(0)" ::: "memory"); pv8(o, V_lds + (b) * F8_KB, pa, r32, hi); } while (0)
  f32x16 pA0, pA1, pB0, pB1; float mnA, mnB, alA, alB; i32x8 pa; const int NT = seq / KVBLK;
  if (wid >= 4) __builtin_amdgcn_s_setprio(1);
  constexpr int SE = 0, SO = 1;
  SLOAD(SE, 0); asm volatile("s_waitcnt vmcnt(0)" ::: "memory"); SWRITE(0, SE); __syncthreads();
  qkt8(pA0, pA1, K_lds, q8, r32, hi); partialSM8<5>(pA0, pA1, m_reg, mnA, alA);
  SLOAD(SO, KVBLK); if (2 < NT) SLOAD(SE, 2 * KVBLK);
  SWAIT(); SWRITE(1, SO); __syncthreads();
  for (int j = 1; j + 1 < NT; j += 2) {
    SBAR(); qkt8(pB0, pB1, K_lds + F8_KB, q8, r32, hi);
    finishSM8(pA0, pA1, alA, l_reg, pa); SBAR();
    SLOAD(SO, (j + 2) * KVBLK); SBAR();
    PV8(0, pa); partialSM8<5>(pB0, pB1, m_reg, mnB, alB);
    __syncthreads(); SWAIT(); SWRITE(0, SE);
    RESC(alB); __syncthreads();
    SBAR(); qkt8(pA0, pA1, K_lds, q8, r32, hi);
    finishSM8(pB0, pB1, alB, l_reg, pa); SBAR();
    if (j + 3 < NT) SLOAD(SE, (j + 3) * KVBLK); SBAR();
    PV8(1, pa); partialSM8<5>(pA0, pA1, m_reg, mnA, alA);
    __syncthreads(); SWAIT(); SWRITE(1, SO);
    RESC(alA); __syncthreads();
  }
  SBAR(); qkt8(pB0, pB1, K_lds + F8_KB, q8, r32, hi);
  finishSM8(pA0, pA1, alA, l_reg, pa); SBAR();
  PV8(0, pa); partialSM8<5>(pB0, pB1, m_reg, mnB, alB);
  __syncthreads(); RESC(alB);
  finishSM8(pB0, pB1, alB, l_reg, pa); SBAR();
  PV8(1, pa);
  if (hi == 0) li_l[r32] = l_reg; asm volatile("s_waitcnt lgkmcnt(0)" ::: "memory");
  float rli[16];
#pragma unroll
  for (int r = 0; r < 16; ++r) rli[r] = __builtin_amdgcn_rcpf(li_l[crow(r, hi)]);
  unsigned char* Ow8 = Ob + (long)(wid * QBLK) * LDO;
#pragma unroll
  for (int r = 0; r < 16; ++r) { int orow = crow(r, hi); const float sc = rli[r] * (float)(1 << OSH);
#pragma unroll
    for (int d0 = 0; d0 < 4; ++d0) Ow8[(long)orow * LDO + d0 * 32 + r32] = (unsigned char)(__builtin_amdgcn_cvt_pk_fp8_f32(o[d0][r] * sc, 0.f, 0, false) & 0xff); }
  __builtin_amdgcn_s_setprio(0);
#undef SLOAD
#undef SWRITE
#undef SWAIT
#undef RESC
#undef PV8
}
#undef F8_MFMA
#undef F8_MFMA_QK
#undef F8_CAT
#undef SBAR
}

constexpr int NWAVES = 8;
constexpr int LDS_BYTES = 135168;
static_assert(att::ATT_LDS <= LDS_BYTES && pg8::STAGE_BYTES <= LDS_BYTES, "LDS map");
constexpr int NPH = 1 + 5 * NCH + 3 + 2 * NCH + 1;

struct Args { const float* in[21]; float* out; unsigned char* ws; int ph_lo, ph_hi; };

__device__ __forceinline__ float wave_sum(float v) {
#pragma unroll
    for (int o = 1; o < 64; o <<= 1) v += __shfl_xor(v, o);
    return v;
}
__device__ __forceinline__ void transpose_item(const float* __restrict__ W, int K, int N, bf16_t* __restrict__ WT, const float* __restrict__ gain, LAS float* scr, int item, int lane) {
    const int nblk = N / 32, kb = item / nblk, nb = item % nblk, k0 = 64 * kb, n0 = 32 * nb;
    { const int kr = lane >> 3, n4 = (lane & 7) * 4; f32x4 w[8];
#pragma unroll
      for (int i = 0; i < 8; ++i) w[i] = *(const f32x4*)(W + (size_t)(k0 + 8 * i + kr) * N + n0 + n4);
#pragma unroll
      for (int i = 0; i < 8; ++i) { const int kk = 8 * i + kr; f32x4 v = w[i]; if (gain) v = v * gain[k0 + kk]; LAS float* d = scr + kk * 33 + n4; d[0] = v.x; d[1] = v.y; d[2] = v.z; d[3] = v.w; } }
    asm volatile("s_waitcnt lgkmcnt(0)" ::: "memory");
    const int c = lane & 7;
#pragma unroll
    for (int j = 0; j < 4; ++j) { const int n = (lane >> 3) + 8 * j; const LAS float* s = scr + (8 * c) * 33 + n;
        u32x4 o; o.x = cvt_pk_bf16(s[0 * 33], s[1 * 33]); o.y = cvt_pk_bf16(s[2 * 33], s[3 * 33]); o.z = cvt_pk_bf16(s[4 * 33], s[5 * 33]); o.w = cvt_pk_bf16(s[6 * 33], s[7 * 33]);
        *(u32x4*)(WT + (size_t)(n0 + n) * K + k0 + 8 * c) = o; }
    asm volatile("s_waitcnt lgkmcnt(0)" ::: "memory");
}
__device__ __forceinline__ void transpose_item_fp8(const float* __restrict__ W, int K, int N, unsigned char* __restrict__ WT, const float* __restrict__ gain, float mul, LAS float* scr, int item, int lane) {
    const int nblk = N / 32, kb = item / nblk, nb = item % nblk, k0 = 64 * kb, n0 = 32 * nb;
    { const int kr = lane >> 3, n4 = (lane & 7) * 4; f32x4 w[8];
#pragma unroll
      for (int i = 0; i < 8; ++i) w[i] = *(const f32x4*)(W + (size_t)(k0 + 8 * i + kr) * N + n0 + n4);
#pragma unroll
      for (int i = 0; i < 8; ++i) { const int kk = 8 * i + kr; f32x4 v = w[i] * mul; if (gain) v = v * gain[k0 + kk]; LAS float* d = scr + kk * 33 + n4; d[0] = v.x; d[1] = v.y; d[2] = v.z; d[3] = v.w; } }
    asm volatile("s_waitcnt lgkmcnt(0)" ::: "memory");
    const int c = lane & 3;
#pragma unroll
    for (int j = 0; j < 2; ++j) { const int n = (lane >> 2) + 16 * j; const LAS float* s = scr + (16 * c) * 33 + n;
        u32x4 o; o.x = pack4_fp8(s[0 * 33], s[1 * 33], s[2 * 33], s[3 * 33]); o.y = pack4_fp8(s[4 * 33], s[5 * 33], s[6 * 33], s[7 * 33]);
        o.z = pack4_fp8(s[8 * 33], s[9 * 33], s[10 * 33], s[11 * 33]); o.w = pack4_fp8(s[12 * 33], s[13 * 33], s[14 * 33], s[15 * 33]);
        *(u32x4*)(WT + (size_t)(n0 + n) * K + k0 + 16 * c) = o; }
    asm volatile("s_waitcnt lgkmcnt(0)" ::: "memory");
}
__device__ __forceinline__ void rms_row_to_fp8(const float* xrow, unsigned char* orow, int lane) {
    const f32x4* xr = (const f32x4*)xrow + lane;
    f32x4 v[8]; float s = 0.f;
#pragma unroll
    for (int j = 0; j < 8; ++j) { v[j] = xr[64 * j]; s += (v[j].x * v[j].x + v[j].y * v[j].y) + (v[j].z * v[j].z + v[j].w * v[j].w); }
    const float rr = __builtin_amdgcn_rsqf(wave_sum(s) * (1.f / DM) + EPS);
    unsigned* o4 = (unsigned*)orow + lane;
#pragma unroll
    for (int j = 0; j < 8; ++j) o4[64 * j] = pack4_fp8(v[j].x * rr, v[j].y * rr, v[j].z * rr, v[j].w * rr);
}
__device__ __forceinline__ void rms_row2_to_fp8(const float* xa, const float* xb, unsigned char* oa, unsigned char* ob, int lane) {
    const f32x4* pa = (const f32x4*)xa + lane; const f32x4* pb = (const f32x4*)xb + lane;
    f32x4 va[8], vb[8]; float sa = 0.f, sb = 0.f;
#pragma unroll
    for (int j = 0; j < 8; ++j) { va[j] = pa[64 * j]; vb[j] = pb[64 * j]; }
#pragma unroll
    for (int j = 0; j < 8; ++j) { sa += (va[j].x * va[j].x + va[j].y * va[j].y) + (va[j].z * va[j].z + va[j].w * va[j].w); sb += (vb[j].x * vb[j].x + vb[j].y * vb[j].y) + (vb[j].z * vb[j].z + vb[j].w * vb[j].w); }
    const float ra = __builtin_amdgcn_rsqf(wave_sum(sa) * (1.f / DM) + EPS), rb = __builtin_amdgcn_rsqf(wave_sum(sb) * (1.f / DM) + EPS);
    unsigned* qa = (unsigned*)oa + lane; unsigned* qb = (unsigned*)ob + lane;
#pragma unroll
    for (int j = 0; j < 8; ++j) { qa[64 * j] = pack4_fp8(va[j].x * ra, va[j].y * ra, va[j].z * ra, va[j].w * ra); qb[64 * j] = pack4_fp8(vb[j].x * rb, vb[j].y * rb, vb[j].z * rb, vb[j].w * rb); }
}
__device__ __forceinline__ void rms_row_to_bf16(const float* xrow, bf16_t* orow, int lane) {
    const f32x4* xr = (const f32x4*)xrow + lane;
    f32x4 v[8]; float s = 0.f;
#pragma unroll
    for (int j = 0; j < 8; ++j) { v[j] = xr[64 * j]; s += (v[j].x * v[j].x + v[j].y * v[j].y) + (v[j].z * v[j].z + v[j].w * v[j].w); }
    const float rr = __builtin_amdgcn_rsqf(wave_sum(s) * (1.f / DM) + EPS);
    u32x2* o8 = (u32x2*)orow + lane;
#pragma unroll
    for (int j = 0; j < 8; ++j) { u32x2 w; w.x = cvt_pk_bf16(v[j].x * rr, v[j].y * rr); w.y = cvt_pk_bf16(v[j].z * rr, v[j].w * rr); o8[64 * j] = w; }
}
__device__ __forceinline__ u32x4 rope_item(const u32x4 raw, const size_t e0, int W, int seq, const float* __restrict__ g, float mul) {
    const int tok = (int)(e0 / (size_t)W), d = (int)(e0 & 127);
    float x[8] = {bf_lo(raw.x), bf_hi(raw.x), bf_lo(raw.y), bf_hi(raw.y), bf_lo(raw.z), bf_hi(raw.z), bf_lo(raw.w), bf_hi(raw.w)};
    float ssq = 0.f;
#pragma unroll
    for (int e = 0; e < 8; ++e) ssq += x[e] * x[e];
    ssq += __shfl_xor(ssq, 1); ssq += __shfl_xor(ssq, 2); ssq += __shfl_xor(ssq, 4); ssq += __shfl_xor(ssq, 8);
    const float rr = __builtin_amdgcn_rsqf(ssq * (1.f / 128.f) + EPS);
    const f32x4 g0 = *(const f32x4*)(g + d), g1 = *(const f32x4*)(g + d + 4);
    x[0] *= rr * g0.x; x[1] *= rr * g0.y; x[2] *= rr * g0.z; x[3] *= rr * g0.w; x[4] *= rr * g1.x; x[5] *= rr * g1.y; x[6] *= rr * g1.z; x[7] *= rr * g1.w;
    const int s = tok % seq; const float pos = (float)((d < 64) ? (s >> 6) : (s & 63));
    const bool first = ((d & 63) < 32); const int fi0 = d & 31;
    float y[8];
#pragma unroll
    for (int e = 0; e < 8; ++e) { const float other = __shfl_xor(x[e], 4);
        const float invf = __builtin_amdgcn_exp2f(-(float)(fi0 + e) * 0.41524101186092029f);
        float rev = pos * invf * 0.15915494309189535f; rev -= rintf(rev);
        const float sn = __builtin_amdgcn_sinf(rev), cs = __builtin_amdgcn_cosf(rev);
        y[e] = (first ? (x[e] * cs - other * sn) : (x[e] * cs + other * sn)) * mul; }
    u32x4 w; w.x = pack4_fp8(y[0], y[1], y[2], y[3]); w.y = pack4_fp8(y[4], y[5], y[6], y[7]); w.z = 0u; w.w = 0u;
    return w;
}
__device__ __forceinline__ void rope_pass(const bf16_t* buf, unsigned char* out8, int W, int ntok, int seq, const float* __restrict__ g, float mul, int gw, int ngw, int lane) {
    const int nitems = (int)(((size_t)ntok * W) / 512);
    for (int it = gw; it < nitems; it += 4 * ngw) {
        size_t e[4]; u32x4 raw[4];
#pragma unroll
        for (int q = 0; q < 4; ++q) { const int iq = it + q * ngw; e[q] = (size_t)(iq < nitems ? iq : it) * 512 + (size_t)lane * 8; raw[q] = *(const u32x4*)(buf + e[q]); }
#pragma unroll
        for (int q = 0; q < 4; ++q) { const u32x4 w = rope_item(raw[q], e[q], W, seq, g, mul); if (it + q * ngw < nitems) { u32x2 o; o.x = w.x; o.y = w.y; *(u32x2*)(out8 + e[q]) = o; } }
    }
}
__device__ __forceinline__ void vt_pass(const bf16_t* gv, unsigned char* VT8, int ntok, int seq, int gw, int ngw, int lane) {
    const int nitems = (ntok / 64) * 2;
    for (int it = gw; it < nitems; it += ngw) {
        const int blk = it >> 1, kvh = it & 1, tok0 = blk * 64, b = tok0 / seq, s0 = tok0 % seq;
        const bf16_t* src = gv + (size_t)(tok0 + lane) * 256 + kvh * 128;
        unsigned char* dst = VT8 + ((size_t)(b * 2 + kvh) * 128) * (size_t)seq + s0 + att::vt_pos(lane);
        u32x4 raw[16];
#pragma unroll
        for (int c = 0; c < 16; ++c) raw[c] = *(const u32x4*)(src + 8 * c);
#pragma unroll
        for (int c = 0; c < 16; ++c) {
            const unsigned a = pack4_fp8(bf_lo(raw[c].x), bf_hi(raw[c].x), bf_lo(raw[c].y), bf_hi(raw[c].y)), d2 = pack4_fp8(bf_lo(raw[c].z), bf_hi(raw[c].z), bf_lo(raw[c].w), bf_hi(raw[c].w));
            unsigned char* dp = dst + (size_t)(8 * c) * seq;
            dp[0] = (unsigned char)(a & 0xff); dp[(size_t)seq] = (unsigned char)((a >> 8) & 0xff); dp[2 * (size_t)seq] = (unsigned char)((a >> 16) & 0xff); dp[3 * (size_t)seq] = (unsigned char)(a >> 24);
            dp[4 * (size_t)seq] = (unsigned char)(d2 & 0xff); dp[5 * (size_t)seq] = (unsigned char)((d2 >> 8) & 0xff); dp[6 * (size_t)seq] = (unsigned char)((d2 >> 16) & 0xff); dp[7 * (size_t)seq] = (unsigned char)(d2 >> 24); }
    }
}

#define XB_TMO      128
#define XB_XCNT(j)  (256  + 64 * (j))
#define XB_XSUB(j)  (1280 + 64 * (j))
#define XB_XGEN(j)  (2304 + 64 * (j))
#define XB_TOP      3328
#define XB_TOPGEN   3392
#define XCD_BAR_WORDS 3456
#define XB_SPIN_CAP (1u << 20)
__device__ __forceinline__ unsigned xb_ld(unsigned* p)              { return __hip_atomic_load(p, __ATOMIC_RELAXED, __HIP_MEMORY_SCOPE_AGENT); }
__device__ __forceinline__ unsigned xb_add(unsigned* p, unsigned v) { return __hip_atomic_fetch_add(p, v, __ATOMIC_RELAXED, __HIP_MEMORY_SCOPE_AGENT); }
__device__ __forceinline__ unsigned xb_xcc_id() { return (unsigned)__builtin_amdgcn_s_getreg((3 << 11) | 20) & 0xFu; }
#define XB_SPIN(cond, bar) do { unsigned _sp = 0; while (cond) { __builtin_amdgcn_s_sleep(1); \
    if ((++_sp & 255u) == 0u) { if (xb_ld(&(bar)[XB_TMO])) break; if (_sp > XB_SPIN_CAP) { atomicAdd(&(bar)[XB_TMO], 1u); break; } } } } while (0)
struct XcdBarrier { unsigned* bar; unsigned x; volatile LAS unsigned* st; };
__device__ __forceinline__ XcdBarrier xcd_barrier_post(unsigned* bar, volatile LAS unsigned* st) {
    XcdBarrier b; b.bar = bar; b.x = xb_xcc_id(); b.st = st;
    if (threadIdx.x == 0) (void)xb_add(&bar[XB_XCNT(b.x)], 1u);
    return b;
}
__device__ __forceinline__ void xcd_barrier_complete(unsigned* bar, unsigned x, unsigned& nloc, unsigned& nx) {
    const unsigned G = gridDim.x * gridDim.y * gridDim.z;
    unsigned sum, cnt, mine, sp = 0u;
    for (;;) {
        sum = 0u; cnt = 0u; mine = 0u;
#pragma unroll
        for (unsigned j = 0; j < 16; ++j) { const unsigned c = xb_ld(&bar[XB_XCNT(j)]); sum += c; cnt += (c > 0u) ? 1u : 0u; mine = (j == x) ? c : mine; }
        if (sum == G) break;
        __builtin_amdgcn_s_sleep(1);
        if ((++sp & 255u) == 0u) { if (xb_ld(&bar[XB_TMO])) break; if (sp > XB_SPIN_CAP) { atomicAdd(&bar[XB_TMO], 1u); break; } }
    }
    nloc = mine > 0u ? mine : 1u; nx = cnt > 0u ? cnt : 1u;
}
__device__ __forceinline__ void xcd_barrier(const XcdBarrier& b) {
    asm volatile("s_waitcnt vmcnt(0)" ::: "memory");
    __syncthreads();
    if (threadIdx.x == 0) {
        unsigned* bar = b.bar;
        __builtin_amdgcn_s_waitcnt(0);
        unsigned nloc = b.st[0], nx = b.st[1];
        if (nloc == 0u) { xcd_barrier_complete(bar, b.x, nloc, nx); b.st[0] = nloc; b.st[1] = nx; }
        const unsigned old = xb_add(&bar[XB_XSUB(b.x)], 1u);
        const unsigned gen = old / nloc;
        if (old + 1u == (gen + 1u) * nloc) {
            __builtin_amdgcn_fence(__ATOMIC_RELEASE, "agent");
            asm volatile("s_waitcnt vmcnt(0)" ::: "memory");
            const unsigned og = xb_add(&bar[XB_TOP], 1u);
            const unsigned tg = og / nx;
            if (og + 1u == (tg + 1u) * nx) xb_add(&bar[XB_TOPGEN], 1u);
            else XB_SPIN(xb_ld(&bar[XB_TOPGEN]) == tg, bar);
            __builtin_amdgcn_fence(__ATOMIC_ACQUIRE, "agent");
            xb_add(&bar[XB_XGEN(b.x)], 1u);
            asm volatile("s_waitcnt vmcnt(0)" ::: "memory");
        } else {
            XB_SPIN(xb_ld(&bar[XB_XGEN(b.x)]) == gen, bar);
            __builtin_amdgcn_fence(__ATOMIC_ACQUIRE, "agent");
            asm volatile("s_waitcnt vmcnt(0)" ::: "memory");
        }
    }
    __syncthreads();
}
constexpr size_t WS_BAR = 655360;
constexpr int LDS_MISC_OFF = 131072 + 2048;
static_assert(WS_BAR >= 3 * (size_t)NTOK * 4 && WS_BAR + XCD_BAR_WORDS * 4 <= WS_WIN && LDS_MISC_OFF + 16 <= LDS_BYTES, "barrier words");
#define AS4 __attribute__((address_space(4)))
#define PP const AS4 Args* ap = (const AS4 Args*)__builtin_amdgcn_kernarg_segment_ptr(); asm volatile("" : "+s"(ap)); \
    int tid_o = threadIdx.x; asm volatile("" : "+v"(tid_o)); const int tid = tid_o, lane = tid & 63; (void)tid; (void)lane; \
    unsigned char* ws = ap->ws; float* out = ap->out; (void)out; \
    float* ss1 = (float*)(ws + WS_SS); float* ss2 = ss1 + NTOK; float* ss3 = ss2 + NTOK; (void)ss1; (void)ss2; (void)ss3; \
    bf16_t* Win_t = (bf16_t*)(ws + WS_WIN); bf16_t* Wpa_t = (bf16_t*)(ws + WS_WPA); bf16_t* Wpb_t = (bf16_t*)(ws + WS_WPB); bf16_t* Wo_t = (bf16_t*)(ws + WS_WO); \
    bf16_t* Wcq_t = (bf16_t*)(ws + WS_WCQ); bf16_t* Wckv_t = (bf16_t*)(ws + WS_WCKV); bf16_t* Wco_t = (bf16_t*)(ws + WS_WCO); \
    bf16_t* Wup_t = (bf16_t*)(ws + WS_WUP); bf16_t* Wdn_t = (bf16_t*)(ws + WS_WDN); \
    bf16_t* memn = (bf16_t*)(ws + WS_MEMN); bf16_t* memkv = (bf16_t*)(ws + WS_MEMKV); \
    bf16_t* XB = (bf16_t*)(ws + WS_XB); bf16_t* QC = (bf16_t*)(ws + WS_QC); bf16_t* Z = (bf16_t*)(ws + WS_Z); bf16_t* HB = (bf16_t*)(ws + WS_Z); unsigned char* XN8 = ws + WS_XN8; unsigned char* Win8 = ws + WS_WIN; (void)XN8; (void)Win8; \
    unsigned char* Q8 = ws + WS_QC; unsigned char* K8 = ws + WS_QC + 32 * MiB; unsigned char* VT8 = ws + WS_QC + 40 * MiB; (void)Q8; (void)K8; (void)VT8; \
    unsigned char* O8A = ws + WS_O8A; unsigned char* O8B = ws + WS_O8B; unsigned char* M8 = (unsigned char*)(Z + Z_NAK); (void)O8A; (void)O8B; (void)M8; \
    (void)Win_t; (void)Wpa_t; (void)Wpb_t; (void)Wo_t; (void)Wcq_t; (void)Wckv_t; (void)Wco_t; (void)Wup_t; (void)Wdn_t; (void)memn; (void)memkv; (void)XB; (void)QC; (void)Z; (void)HB;
__global__ void __launch_bounds__(NWAVES * 64, 2) mega_fwd(Args args) {
    extern __shared__ __attribute__((aligned(16))) unsigned char lds[];
    LAS unsigned char* L = (LAS unsigned char*)lds;
    cg::grid_group grid = cg::this_grid();
    const int tid = threadIdx.x, lane = tid & 63, wave = __builtin_amdgcn_readfirstlane(tid >> 6);
    const int G = gridDim.x, bx = blockIdx.x;
    const int vcu = (G % 8 == 0) ? (bx % 8) * (G / 8) + bx / 8 : bx;
    const int gw = vcu * NWAVES + wave, NGW = G * NWAVES;
    const int lo = args.ph_lo, hi = args.ph_hi; int ph = 0;
    volatile LAS unsigned* bst = (volatile LAS unsigned*)(L + LDS_MISC_OFF);
    if (threadIdx.x < 4) bst[threadIdx.x] = 0u;
    __syncthreads();
    XcdBarrier xbar; xbar.bar = (unsigned*)(args.ws + WS_BAR); xbar.x = 0; xbar.st = bst;
    if (hi - lo > 1) xbar = xcd_barrier_post((unsigned*)(args.ws + WS_BAR), bst);
#ifndef PH_MASK
#define PH_MASK 0xffff
#endif
#ifndef DUP_P0
#define DUP_P0 0
#endif
#ifndef DUP_A
#define DUP_A 0
#endif
#ifndef DUP_GQA
#define DUP_GQA 0
#endif
#ifndef DUP_NA
#define DUP_NA 0
#endif
#ifndef DUP_I
#define DUP_I 0
#endif
#ifndef DUP_SYNC
#define DUP_SYNC 0
#endif
#ifndef DUP_G
#define DUP_G 0
#endif
#ifndef DUP_F
#define DUP_F 0
#endif
#define PHON(b) ((PH_MASK >> (b)) & 1)
#define RUN() (ph >= lo && ph < hi)
#define SEAM() do { if (ph >= lo && ph + 1 < hi) { if (lo < 0) grid.sync(); else xcd_barrier(xbar); for (int r_ = 0; r_ < DUP_SYNC; ++r_) xcd_barrier(xbar); } ++ph; } while (0)

    if (PHON(0) && RUN()) { PP
      _Pragma("unroll 1") for (int rep = 0; rep <= DUP_P0; ++rep) {
        for (int i = gw * 64 + lane; i < 3 * NTOK; i += NGW * 64) ss1[i] = 0.f;
        LAS float* scr = (LAS float*)(L + wave * 16384);
        constexpr int I_IN = (DM / 64) * (DIN / 32), I_PA = (1024 / 64) * (DM / 32), I_O = (DM / 64) * (DM / 32), I_CQ = (DM / 64) * (CWID / 32), I_CKV = (DM / 64) * (1024 / 32),
                      I_CO = (CWID / 64) * (DM / 32), I_UP = (DM / 64) * (DFF / 32), I_DN = (DFF / 64) * (DM / 32);
        constexpr int NITEMS = I_IN + 2 * I_PA + I_O + I_CQ + I_CKV + I_CO + I_UP + I_DN;
        for (int it = gw; it < NITEMS; it += NGW) {
            int r = it;
            if (r < I_IN) { transpose_item_fp8(ap->in[5], DM, DIN, Win8, ap->in[4], (float)(1 << W8_SHIFT), scr, r, lane); continue; } r -= I_IN;
            if (r < I_PA) { transpose_item_fp8(ap->in[9], 1024, DM, (unsigned char*)Wpa_t, nullptr, (float)(1 << W8_SHIFT), scr, r, lane); continue; } r -= I_PA;
            if (r < I_PA) { transpose_item_fp8(ap->in[10], 1024, DM, (unsigned char*)Wpb_t, nullptr, (float)(1 << W8_SHIFT), scr, r, lane); continue; } r -= I_PA;
            if (r < I_O) { transpose_item_fp8(ap->in[11], DM, DM, (unsigned char*)Wo_t, nullptr, (float)(1 << W8_SHIFT), scr, r, lane); continue; } r -= I_O;
            if (r < I_CQ) { transpose_item(ap->in[14], DM, CWID, Wcq_t, ap->in[12], scr, r, lane); continue; } r -= I_CQ;
            if (r < I_CKV) { transpose_item(ap->in[15], DM, 1024, Wckv_t, ap->in[13], scr, r, lane); continue; } r -= I_CKV;
            if (r < I_CO) { transpose_item(ap->in[16], CWID, DM, Wco_t, nullptr, scr, r, lane); continue; } r -= I_CO;
            if (r < I_UP) { transpose_item(ap->in[18], DM, DFF, Wup_t, ap->in[17], scr, r, lane); continue; } r -= I_UP;
            transpose_item(ap->in[19], DFF, DM, Wdn_t, nullptr, scr, r, lane);
        }
        for (int m = gw; m < NTOK; m += 2 * NGW) {
            const int m2 = m + NGW; const float* xa = (m < 32768) ? ap->in[0] + (size_t)m * DM : ap->in[1] + (size_t)(m - 32768) * DM;
            if (m2 < NTOK) { const float* xb2 = (m2 < 32768) ? ap->in[0] + (size_t)m2 * DM : ap->in[1] + (size_t)(m2 - 32768) * DM; rms_row2_to_fp8(xa, xb2, XN8 + (size_t)m * DM, XN8 + (size_t)m2 * DM, lane); }
            else rms_row_to_fp8(xa, XN8 + (size_t)m * DM, lane); }
        for (int m = gw; m < NMEMROWS; m += NGW) { const float* xr = (m < 1024) ? ap->in[2] + (size_t)m * DM : ap->in[3] + (size_t)(m - 1024) * DM; rms_row_to_bf16(xr, memn + (size_t)m * DM, lane); }
      }
    }
    SEAM();

#pragma unroll 1
    for (int c = 0; c < NCH; ++c) {
        const int row0 = c * 32768, CR = (c == 0) ? 32768 : 16384, nb = (c == 0) ? 4 : 1, seq = (c == 0) ? 8192 : 16384;
        if (PHON(1) && RUN()) { PP
            pg8::Gemm g{(const bf16_t*)(XN8 + (size_t)row0 * DM), (const bf16_t*)Win8, CR, DIN, DM / 2, DM / 2, 0}; pg8::StaticOrder S; S.init(CR, DIN, G, bx);
            pg8::EpiB E{Z, 0, 1, nullptr, 0};
            _Pragma("unroll 1") for (int rep = 0; rep <= DUP_A; ++rep)
            pg8::gemm_phase<pg8::EpiB, pg8::StaticOrder, true>(L, g, S, E);
        }
        SEAM();
        if (PHON(2) && RUN()) { PP
            rope_pass(Z + Z_GQ, Q8, 1024, CR, seq, ap->in[7], att::QPRE, gw, NGW, lane);
            rope_pass(Z + Z_GK, K8, 256, CR, seq, ap->in[8], 1.0f, gw, NGW, lane);
            vt_pass(Z + Z_GV, VT8, CR, seq, gw, NGW, lane);
        }
        SEAM();
        if (PHON(3) && RUN()) { PP
            const int nqb = seq / 256, NU = nb * 8 * nqb, nper = (NU + G - 1) / G;
            att::NaCtx na0{0, 0, 0, 0, 0, nullptr};
            bf16_t* DUMMY = (bf16_t*)(ws + 981 * MiB); (void)DUMMY;
            _Pragma("unroll 1") for (int rep = 0; rep <= DUP_GQA; ++rep)
            for (int i = 0; i < nper; ++i) { const int u = vcu * nper + i; if (u >= NU) break;
                const int qb = u % nqb; int t = u / nqb; const int gq = t % 4; t /= 4; const int kvh = t % 2, b = t / 2, h = kvh * 4 + gq;
                const size_t qoff = ((size_t)b * seq + (size_t)qb * 256) * 1024 + h * 128;
                att::attn_body_f8<1024, 256, 1024, OB_SHIFT>(Q8 + qoff, K8 + (size_t)b * seq * 256 + kvh * 128, VT8 + ((size_t)(b * 2 + kvh) * 128) * (size_t)seq, (long)seq, O8B + qoff, seq, (char*)lds);
            }
            __syncthreads();
            const int rows = seq / 64;
            _Pragma("unroll 1") for (int rep = 0; rep <= DUP_NA; ++rep)
            for (int i = 0; i < nper; ++i) { const int u = vcu * nper + i; if (u >= NU) break;
                const int h = u % 8; int t = u / 8; const int rg = t % nqb, b = t / nqb, R0 = 4 * rg;
                int kr0 = R0 - 4; kr0 = kr0 < 0 ? 0 : (kr0 > rows - 12 ? rows - 12 : kr0);
                LAS float* tb = (LAS float*)(L + att::NA_TBL_OFF) + att::NA_TBL_PAD;
                if (tid < 15 * 32) { const int dr = tid >> 5, dc = tid & 31; tb[tid] = (dc < 31) ? ap->in[6][(h * 15 + dr) * 31 + dc] * (1.0f / att::SCALE) : 0.f; }
                att::NaCtx na; na.r = R0 + (wave >> 1); na.rs = na.r - 4 < 0 ? 0 : (na.r - 4 > rows - 8 ? rows - 8 : na.r - 4);
                na.c = (wave & 1) * 32 + (lane & 31); na.cs = na.c - 8 < 0 ? 0 : (na.c - 8 > 48 ? 48 : na.c - 8); na.kr0 = kr0; na.tbl = tb;
                bf16_t* Q = Z + Z_NAQ + ((size_t)b * seq + (size_t)R0 * 64) * 1024 + h * 128;
                const bf16_t* Kp = Z + Z_NAK + ((size_t)b * seq + (size_t)kr0 * 64) * 1024 + h * 128; const bf16_t* Vp = Z + Z_NAV + ((size_t)b * seq + (size_t)kr0 * 64) * 1024 + h * 128;
                att::attn_body<1024, 1024, 1024, true, OA_SHIFT>(Q, Kp, Vp, (bf16_t*)(O8A + ((size_t)b * seq + (size_t)R0 * 64) * 1024 + h * 128), 12 * 64, (char*)lds, na);
            }
            __syncthreads();
        }
        SEAM();
        if (PHON(4) && RUN()) { PP
            { pg8::Gemm g{(const bf16_t*)O8A, Wpa_t, CR, DM, 512, 512, OA_SHIFT}; pg8::StaticOrder S; S.init(CR, DM, G, bx);
              pg8::EpiGate E{Z + Z_GA, Z + Z_GA, nullptr, 0}; pg8::gemm_phase<pg8::EpiGate, pg8::StaticOrder, true>(L, g, S, E); }
            { pg8::Gemm g{(const bf16_t*)O8B, Wpb_t, CR, DM, 512, 512, OB_SHIFT}; pg8::StaticOrder S; S.init(CR, DM, G, bx);
              pg8::EpiGate E{Z + Z_GB, Z + Z_GA, M8, 1}; pg8::gemm_phase<pg8::EpiGate, pg8::StaticOrder, true>(L, g, S, E); }
        }
        SEAM();
        if (PHON(5) && RUN()) { PP
            const float* xin = (c == 0) ? ap->in[0] : ap->in[1];
            pg8::Gemm g{(const bf16_t*)M8, Wo_t, CR, DM, DM / 2, DM / 2, MX_SHIFT}; pg8::StaticOrder S; S.init(CR, DM, G, bx);
            pg8::EpiRes<true> E{xin, nullptr, XB + (size_t)row0 * DM, ss1 + row0};
            pg8::gemm_phase<pg8::EpiRes<true>, pg8::StaticOrder, true>(L, g, S, E);
        }
        SEAM();
    }
    if (PHON(6) && RUN()) { PP
        { pg8::Gemm g{XB, Wcq_t, NTOK, CWID, DM, DM, 0}; pg8::StaticOrder S; S.init(NTOK, CWID, G, bx);
          pg8::EpiB E{QC, CWID, 0, ss1, 0};
          _Pragma("unroll 1") for (int rep = 0; rep <= DUP_F; ++rep)
          pg8::gemm_phase<pg8::EpiB, pg8::StaticOrder>(L, g, S, E); }
        { pg8::Gemm g{memn, Wckv_t, NMEMROWS, 1024, DM, DM, 0}; pg8::StaticOrder S; S.init(NMEMROWS, 1024, G, (bx + G / 2) % G);
          pg8::EpiB E{memkv, 1024, 0, nullptr, 0}; pg8::gemm_phase<pg8::EpiB, pg8::StaticOrder>(L, g, S, E); }
    }
    SEAM();
    if (PHON(7) && RUN()) { PP
        const int NU = (NTOK / 256) * 4, nper = (NU + G - 1) / G;
        att::NaCtx na0{0, 0, 0, 0, 0, nullptr};
        bf16_t* DUMMY = (bf16_t*)(ws + 981 * MiB); (void)DUMMY;
        _Pragma("unroll 1") for (int rep = 0; rep <= DUP_G; ++rep)
        for (int i = 0; i < nper; ++i) { const int u = vcu * nper + i; if (u >= NU) break;
            const int h = u % 4, rb = u / 4, b = (rb < 128) ? (rb >> 5) : 4;
            bf16_t* Q = QC + (size_t)rb * 256 * CWID + h * 128;
            const bf16_t* Kp = memkv + (size_t)b * 256 * 1024 + h * 128; const bf16_t* Vp = Kp + 512;
            att::attn_body<512, 1024, 512, false>(Q, Kp, Vp, (rep < DUP_G) ? DUMMY + (Q - QC) : Q, 256, (char*)lds, na0);
        }
        __syncthreads();
    }
    SEAM();
    if (PHON(8) && RUN()) { PP
        pg8::Gemm g{QC, Wco_t, NTOK, DM, CWID, CWID, 0}; pg8::StaticOrder S; S.init(NTOK, DM, G, bx);
        pg8::EpiRes<false> E{nullptr, XB, XB, ss2}; pg8::gemm_phase<pg8::EpiRes<false>, pg8::StaticOrder>(L, g, S, E);
    }
    SEAM();
#pragma unroll 1
    for (int c = 0; c < NCH; ++c) {
        const int row0 = c * 32768, CR = (c == 0) ? 32768 : 16384;
        if (PHON(9) && RUN()) { PP
            pg8::Gemm g{XB + (size_t)row0 * DM, Wup_t, CR, DFF, DM, DM, 0}; pg8::StaticOrder S; S.init(CR, DFF, G, bx);
            pg8::EpiB E{HB, DFF, 0, ss2 + row0, 1};
            _Pragma("unroll 1") for (int rep = 0; rep <= DUP_I; ++rep)
            pg8::gemm_phase<pg8::EpiB, pg8::StaticOrder>(L, g, S, E);
        }
        SEAM();
        if (PHON(10) && RUN()) { PP
            pg8::Gemm g{HB, Wdn_t, CR, DM, DFF, DFF, 0}; pg8::StaticOrder S; S.init(CR, DM, G, bx);
            pg8::EpiRes<false> E{nullptr, XB + (size_t)row0 * DM, XB + (size_t)row0 * DM, ss3 + row0}; pg8::gemm_phase<pg8::EpiRes<false>, pg8::StaticOrder>(L, g, S, E);
        }
        SEAM();
    }
    if (PHON(11) && RUN()) { PP
        const float* gf = ap->in[20];
        f32x4 gv[8];
#pragma unroll
        for (int j = 0; j < 8; ++j) gv[j] = *((const f32x4*)gf + lane + 64 * j);
        for (int m = gw; m < NTOK; m += NGW) { const float rr = __builtin_amdgcn_rsqf(ss3[m] * (1.f / DM) + EPS);
            const u32x2* xb = (const u32x2*)(XB + (size_t)m * DM) + lane; f32x4* xr = (f32x4*)(out + (size_t)m * DM) + lane;
            u32x2 r[8];
#pragma unroll
            for (int j = 0; j < 8; ++j) r[j] = xb[64 * j];
#pragma unroll
            for (int j = 0; j < 8; ++j) { f32x4 v = (f32x4){bf_lo(r[j].x), bf_hi(r[j].x), bf_lo(r[j].y), bf_hi(r[j].y)}; v = v * rr * gv[j]; xr[64 * j] = v; } }
    }
#undef RUN
#undef SEAM
}

extern "C" void kernel_launch(void* const* d_in, const int* in_sizes, int n_in, void* d_out, int out_size, void* d_ws, size_t ws_size, hipStream_t stream) {
    static int grid = 0;
    if (grid == 0) {
        if (n_in != 21 || out_size != NTOK * DM || ws_size < WS_END) { fprintf(stderr, "kernel_launch: unexpected shapes n_in %d out %d ws %zu\n", n_in, out_size, ws_size); grid = -1; return; }
        int dev = 0, cus = 0, per_cu = 0;
        if (hipGetDevice(&dev) != hipSuccess || hipDeviceGetAttribute(&cus, hipDeviceAttributeMultiprocessorCount, dev) != hipSuccess) { grid = -1; return; }
        if (hipFuncSetAttribute((const void*)mega_fwd, hipFuncAttributeMaxDynamicSharedMemorySize, LDS_BYTES) != hipSuccess) { fprintf(stderr, "kernel_launch: hipFuncSetAttribute failed\n"); grid = -1; return; }
        if (hipOccupancyMaxActiveBlocksPerMultiprocessor(&per_cu, (const void*)mega_fwd, NWAVES * 64, LDS_BYTES) != hipSuccess || per_cu < 1) per_cu = 1;
        (void)hipGetLastError();
        grid = cus * 1;
        (void)per_cu;
    }
    if (grid < 0) return;
    Args a{};
    for (int i = 0; i < 21; ++i) a.in[i] = (const float*)d_in[i];
    a.out = (float*)d_out; a.ws = (unsigned char*)d_ws;
#if MK_MULTI
    for (int p = 0; p < NPH; ++p) { a.ph_lo = p; a.ph_hi = p + 1; hipLaunchKernelGGL(mega_fwd, dim3(grid), dim3(NWAVES * 64), LDS_BYTES, stream, a); }
#else
    a.ph_lo = 0; a.ph_hi = NPH;
    if (hipMemsetAsync((char*)d_ws + WS_BAR, 0, XCD_BAR_WORDS * 4, stream) != hipSuccess) { fprintf(stderr, "kernel_launch: memset of barrier words failed\n"); return; }
    void* kargs[] = {&a};
    hipError_t e = hipLaunchCooperativeKernel((const void*)mega_fwd, dim3(grid), dim3(NWAVES * 64), kargs, LDS_BYTES, stream);
    if (e != hipSuccess) fprintf(stderr, "cooperative launch failed: %s (grid %d)\n", hipGetErrorString(e), grid);
#endif
}
```

```cpp
#include <hip/hip_runtime.h>
#include <hip/hip_bf16.h>
#include <hip/hip_cooperative_groups.h>
#include <cstdio>
#include <cstdint>
#include <cmath>
#include <type_traits>
namespace cg = cooperative_groups;

#ifndef MK_MULTI
#define MK_MULTI 0
#endif

#define LAS __attribute__((address_space(3)))
typedef unsigned short bf16_t;
typedef short bf16x8 __attribute__((ext_vector_type(8)));
typedef short s16x4 __attribute__((ext_vector_type(4)));
typedef float f32x2 __attribute__((ext_vector_type(2)));
typedef float f32x4 __attribute__((ext_vector_type(4)));
typedef float f32x16 __attribute__((ext_vector_type(16)));
typedef unsigned u32x2 __attribute__((ext_vector_type(2)));
typedef unsigned u32x4 __attribute__((ext_vector_type(4)));
typedef int i32x4 __attribute__((ext_vector_type(4)));
typedef int i32x8 __attribute__((ext_vector_type(8)));

constexpr int DM = 2048, NTOK = 49152, CH = 32768  , NCH = 2, DIN = 8704, DFF = 8192, NMEMROWS = 1280, CWID = 512;
constexpr float EPS = 1e-6f;
constexpr size_t MiB = 1u << 20;
constexpr size_t WS_SS = 0;
constexpr size_t WS_WIN = 1 * MiB, WS_WPA = 35 * MiB, WS_WPB = 39 * MiB, WS_WO = 43 * MiB, WS_WCQ = 51 * MiB, WS_WCKV = 53 * MiB,
                 WS_WCO = 57 * MiB, WS_WUP = 59 * MiB, WS_WDN = 91 * MiB, WS_MEMN = 123 * MiB, WS_MEMKV = 128 * MiB, WS_XB = 131 * MiB,
                 WS_QC = 323 * MiB, WS_Z = 371 * MiB, WS_ZEND = 915 * MiB, WS_XN8 = WS_XB + 96 * MiB  , WS_O8A = 916 * MiB, WS_O8B = 948 * MiB  , WS_END = 980 * MiB;
constexpr size_t Z_NAQ = 0, Z_NAK = (size_t)CH * 1024, Z_NAV = (size_t)2 * CH * 1024, Z_GQ = (size_t)3 * CH * 1024, Z_GK = (size_t)4 * CH * 1024,
                 Z_GV = Z_GK + (size_t)CH * 256, Z_GA = Z_GV + (size_t)CH * 256, Z_GB = Z_GA + (size_t)CH * 2048;
static_assert((Z_GB + (size_t)CH * 2048) * 2 <= WS_ZEND - WS_Z, "z region");
static_assert((size_t)CH * DFF * 2 <= WS_ZEND - WS_Z, "h overlay");
constexpr int W8_SHIFT = 5, OA_SHIFT = 4, OB_SHIFT = 5, MX_SHIFT = 4;

__device__ __forceinline__ unsigned cvt_pk_bf16(float lo, float hi) { unsigned r; asm volatile("v_cvt_pk_bf16_f32 %0, %1, %2" : "=v"(r) : "v"(lo), "v"(hi)); return r; }
__device__ __forceinline__ unsigned pack4_fp8(float a, float b, float c, float d) { int r = 0; r = __builtin_amdgcn_cvt_pk_fp8_f32(a, b, r, false); r = __builtin_amdgcn_cvt_pk_fp8_f32(c, d, r, true); return (unsigned)r; }
__device__ __forceinline__ float bf_lo(unsigned w) { return __uint_as_float(w << 16); }
__device__ __forceinline__ float bf_hi(unsigned w) { return __uint_as_float(w & 0xffff0000u); }
__device__ __forceinline__ float sigmoidf_(float x) { return __builtin_amdgcn_rcpf(1.0f + __builtin_amdgcn_exp2f(-1.4426950408889634f * x)); }

namespace pg8 {
constexpr int BM = 256, BK = 64, HALF = 128, HTB = HALF * BK * 2, STAGE_BYTES = 8 * HTB, NXCD = 8, WGM = 8;
__host__ __device__ __forceinline__ int lds_byte(int r, int c) { const int st = (r >> 4) * 2 + (c >> 5), rr = r & 15, cc = c & 31, ob = rr * 64 + cc * 2; return st * 1024 + (ob ^ (((ob >> 9) & 1) << 5)); }
__host__ __device__ __forceinline__ void stage_rc(int b, int& R, int& C) { const int st = b / 1024, sb = b % 1024, swz = sb ^ (((sb >> 9) & 1) << 5); R = (st >> 1) * 16 + swz / 64; C = (st & 1) * 32 + (swz % 64) / 2; }
__host__ __device__ __forceinline__ int perm32(int rho) { const int n = rho >> 4, i = rho & 15; return 8 * (i >> 2) + 4 * n + (i & 3); }
struct Unit { int pm, pn; };
struct Gemm { const bf16_t* A; const bf16_t* Bt; int M, N, K, lda; int xshift; };
struct StaticOrder {
    int nM, nN, nwg, G, c;
    __device__ void init(int M, int N, int G_, int c_) { nM = M / BM; nN = N / BM; nwg = nM * nN; G = G_; c = c_; }
    __device__ bool next(int i, Unit& u) const {
        const long L = (long)i * G + c; if (L >= nwg) return false;
        int wgid = (int)L; { const int q = nwg / NXCD, r = nwg % NXCD, xcd = wgid % NXCD, off = wgid / NXCD; wgid = (xcd < r ? xcd * (q + 1) : r * (q + 1) + (xcd - r) * q) + off; }
        const int nig = WGM * nN, gid = wgid / nig, fm = gid * WGM, gsz = (nM - fm) < WGM ? (nM - fm) : WGM;
        u.pm = fm + ((wgid % nig) % gsz); u.pn = (wgid % nig) / gsz; return true;
    }
};

struct EpiB {
    static constexpr bool PERM = true;
    bf16_t* O; int ldc; int route; const float* ss; int act;
    __device__ __forceinline__ void operator()(const f32x4 (&acc)[2][2][4][2], const Unit& u, int wr, int wc, int fr, int fq) const {
        const int row0 = u.pm * BM + wr * 64 + fr; bf16_t* base = O; int ld = ldc, colt = u.pn * BM;
        if (route) { const int pn = u.pn;
            if (pn < 16) { base += (size_t)(pn >> 2) * ((size_t)CH * 1024); ld = 1024; colt = (pn & 3) * 256; }
            else if (pn < 18) { base += Z_GK + (size_t)(pn - 16) * ((size_t)CH * 256); ld = 256; colt = 0; }
            else { base += Z_GA + (size_t)((pn - 18) >> 3) * ((size_t)CH * 2048); ld = 2048; colt = ((pn - 18) & 7) * 256; } }
        const int col0 = colt + wc * 32 + 8 * fq;
#pragma unroll
        for (int ai = 0; ai < 2; ++ai)
#pragma unroll
            for (int m = 0; m < 4; ++m) { const int row = row0 + ai * HALF + m * 16; float sc = 1.f;
                if (ss) sc = __builtin_amdgcn_rsqf(ss[row] * (1.0f / DM) + EPS);
                bf16_t* rowp = base + (size_t)row * ld + col0;
#pragma unroll
                for (int bj = 0; bj < 2; ++bj) { f32x4 v0 = acc[ai][bj][m][0] * sc, v1 = acc[ai][bj][m][1] * sc;
                    if (act) {
#pragma unroll
                        for (int e = 0; e < 4; ++e) { float a = fmaxf(v0[e], 0.f), b = fmaxf(v1[e], 0.f); v0[e] = a * a; v1[e] = b * b; } }
                    u32x4 w; w.x = cvt_pk_bf16(v0[0], v0[1]); w.y = cvt_pk_bf16(v0[2], v0[3]); w.z = cvt_pk_bf16(v1[0], v1[1]); w.w = cvt_pk_bf16(v1[2], v1[3]);
                    *(u32x4*)(rowp + bj * HALF) = w; } }
    }
};
struct EpiGate {
    static constexpr bool PERM = true;
    const bf16_t* G; bf16_t* T; unsigned char* M8; int second;
    __device__ __forceinline__ void ldgrp(u32x4 (&gg)[2], u32x4 (&tt)[2], size_t ro) const {
#pragma unroll
        for (int bj = 0; bj < 2; ++bj) { gg[bj] = *(const u32x4*)(G + ro + bj * HALF); if (second) tt[bj] = *(const u32x4*)(T + ro + bj * HALF); else tt[bj] = (u32x4){0u, 0u, 0u, 0u}; }
    }
    __device__ __forceinline__ void operator()(const f32x4 (&acc)[2][2][4][2], const Unit& u, int wr, int wc, int fr, int fq) const {
        const int row0 = u.pm * BM + wr * 64 + fr, col0 = u.pn * BM + wc * 32 + 8 * fq;
        u32x4 gg[2], tt[2], gn[2], tn[2];
        ldgrp(gg, tt, (size_t)row0 * 2048 + col0);
#pragma unroll
        for (int gi = 0; gi < 8; ++gi) { const int ai = gi >> 2, m = gi & 3; const size_t ro = (size_t)(row0 + ai * HALF + m * 16) * 2048 + col0;
            if (gi < 7) ldgrp(gn, tn, (size_t)(row0 + ((gi + 1) >> 2) * HALF + ((gi + 1) & 3) * 16) * 2048 + col0);
#pragma unroll
            for (int bj = 0; bj < 2; ++bj) { const u32x4 g = gg[bj];
                f32x4 v0 = acc[ai][bj][m][0], v1 = acc[ai][bj][m][1];
                v0[0] *= sigmoidf_(bf_lo(g.x)); v0[1] *= sigmoidf_(bf_hi(g.x)); v0[2] *= sigmoidf_(bf_lo(g.y)); v0[3] *= sigmoidf_(bf_hi(g.y));
                v1[0] *= sigmoidf_(bf_lo(g.z)); v1[1] *= sigmoidf_(bf_hi(g.z)); v1[2] *= sigmoidf_(bf_lo(g.w)); v1[3] *= sigmoidf_(bf_hi(g.w));
                if (second) { const u32x4 t = tt[bj];
                    v0[0] += bf_lo(t.x); v0[1] += bf_hi(t.x); v0[2] += bf_lo(t.y); v0[3] += bf_hi(t.y);
                    v1[0] += bf_lo(t.z); v1[1] += bf_hi(t.z); v1[2] += bf_lo(t.w); v1[3] += bf_hi(t.w);
                    constexpr float MS = (float)(1 << MX_SHIFT); v0 = v0 * MS; v1 = v1 * MS;
                    u32x2 w; w.x = pack4_fp8(v0[0], v0[1], v0[2], v0[3]); w.y = pack4_fp8(v1[0], v1[1], v1[2], v1[3]);
                    *(u32x2*)(M8 + ro + bj * HALF) = w; }
                else { u32x4 w; w.x = cvt_pk_bf16(v0[0], v0[1]); w.y = cvt_pk_bf16(v0[2], v0[3]); w.z = cvt_pk_bf16(v1[0], v1[1]); w.w = cvt_pk_bf16(v1[2], v1[3]);
                    *(u32x4*)(T + ro + bj * HALF) = w; } }
#pragma unroll
            for (int bj = 0; bj < 2; ++bj) { gg[bj] = gn[bj]; tt[bj] = tn[bj]; }
        }
    }
};
template <bool XF>
struct EpiRes {
    static constexpr bool PERM = false;
    const float* Xf; const bf16_t* Xb; bf16_t* XB; float* ss;
    typedef typename std::conditional<XF, f32x4, u32x2>::type raw_t;
    __device__ __forceinline__ void ldgrp(raw_t (&r)[2][2], size_t ro) const {
#pragma unroll
        for (int bj = 0; bj < 2; ++bj)
#pragma unroll
            for (int n = 0; n < 2; ++n) { const size_t off = ro + bj * HALF + n * 16;
                if constexpr (XF) r[bj][n] = *(const f32x4*)(Xf + off); else r[bj][n] = *(const u32x2*)(Xb + off); }
    }
    __device__ __forceinline__ void operator()(const f32x4 (&acc)[2][2][4][2], const Unit& u, int wr, int wc, int fr, int fq) const {
        const int row0 = u.pm * BM + wr * 64 + fr, col0 = u.pn * BM + wc * 32 + 4 * fq;
        raw_t cur[2][2], nxt[2][2];
        ldgrp(cur, (size_t)row0 * 2048 + col0);
#pragma unroll
        for (int g = 0; g < 8; ++g) { const int ai = g >> 2, m = g & 3;
            if (g < 7) ldgrp(nxt, (size_t)(row0 + ((g + 1) >> 2) * HALF + ((g + 1) & 3) * 16) * 2048 + col0);
            const int row = row0 + ai * HALF + m * 16; const size_t ro = (size_t)row * 2048 + col0; float s = 0.f;
#pragma unroll
            for (int bj = 0; bj < 2; ++bj)
#pragma unroll
                for (int n = 0; n < 2; ++n) { const size_t off = ro + bj * HALF + n * 16;
                    f32x4 x;
                    if constexpr (XF) x = cur[bj][n]; else x = (f32x4){bf_lo(cur[bj][n].x), bf_hi(cur[bj][n].x), bf_lo(cur[bj][n].y), bf_hi(cur[bj][n].y)};
                    const f32x4 v = x + acc[ai][bj][m][n];
                    s += (v[0] * v[0] + v[1] * v[1]) + (v[2] * v[2] + v[3] * v[3]);
                    u32x2 w; w.x = cvt_pk_bf16(v[0], v[1]); w.y = cvt_pk_bf16(v[2], v[3]); *(u32x2*)(XB + off) = w; }
            s += __shfl_xor(s, 16); s += __shfl_xor(s, 32);
            if (fq == 0) unsafeAtomicAdd(ss + row, s);
#pragma unroll
            for (int bj = 0; bj < 2; ++bj)
#pragma unroll
                for (int n = 0; n < 2; ++n) cur[bj][n] = nxt[bj][n];
        }
    }
};

template <class Epi, class Sched, bool FP8 = false>
__device__ __forceinline__ void gemm_phase(LAS unsigned char* lds, const Gemm g, const Sched& S, const Epi& E) {
    int tid_ = threadIdx.x; asm volatile("" : "+v"(tid_));
    const int tid = tid_, wid = __builtin_amdgcn_readfirstlane(tid >> 6), lane = tid & 63, wr = wid >> 2, wc = wid & 3, fr = lane & 15, fq = lane >> 4;
    const int K = g.K, nt = K / BK, lda = g.lda;
    unsigned voffA[2], voffB[2];
#pragma unroll
    for (int i = 0; i < 2; ++i) { int R, C; stage_rc(tid * 16 + i * 8192, R, C); const int Rb = Epi::PERM ? ((R & ~31) + perm32(R & 31)) : R;
        voffA[i] = (unsigned)(R * lda + C) * 2u; voffB[i] = (unsigned)(Rb * K + C) * 2u; }
    const size_t kstep = (size_t)(BK * 2);
    const size_t hstepA = (size_t)HALF * lda * 2, hstepB = (size_t)HALF * K * 2, tstepA = 2 * hstepA, tstepB = 2 * hstepB;
    const unsigned ldsw = (unsigned)wid * 1024u;
    const int aoff = lds_byte(wr * 64 + fr, fq * 8), boff = lds_byte(wc * 32 + fr, fq * 8);
#define PG8_SA(b, h) (((b) * 2 + (h)) * HTB)
#define PG8_SB(b, h) ((4 + (b) * 2 + (h)) * HTB)
#define PG8_STAGE(bufoff, gbase, voff) do { _Pragma("unroll") for (int _i = 0; _i < 2; ++_i) \
        __builtin_amdgcn_global_load_lds((const unsigned*)((const char*)(gbase) + (voff)[_i]), (LAS unsigned*)(lds + (bufoff) + ldsw + _i * 8192), 16, 0, 0); } while (0)
#define PG8_LD2(p) __builtin_shufflevector(*(const LAS i32x4*)(p), *(const LAS i32x4*)((p) + 1024), 0, 1, 2, 3, 4, 5, 6, 7)
#define PG8_LDA(dst, b, h) do { _Pragma("unroll") for (int m = 0; m < 4; ++m) dst[m] = PG8_LD2(lds + PG8_SA(b, h) + aoff + m * 2048); } while (0)
#define PG8_LDB(dst, b, h) do { _Pragma("unroll") for (int n = 0; n < 2; ++n) dst[n] = PG8_LD2(lds + PG8_SB(b, h) + boff + n * 2048); } while (0)
#define PG8_LO(x) __builtin_bit_cast(bf16x8, __builtin_shufflevector(x, x, 0, 1, 2, 3))
#define PG8_HI(x) __builtin_bit_cast(bf16x8, __builtin_shufflevector(x, x, 4, 5, 6, 7))
#define PG8_MMA(ai, bj, At, Bt) do { __builtin_amdgcn_s_setprio(1); _Pragma("unroll") for (int m = 0; m < 4; ++m) _Pragma("unroll") for (int n = 0; n < 2; ++n) { \
        if constexpr (FP8) asm volatile("v_mfma_scale_f32_16x16x128_f8f6f4 %0, %1, %2, %0, %3, %4 op_sel_hi:[0,0,0]" : "+v"(acc[ai][bj][m][n]) : "v"(Bt[n]), "v"(At[m]), "v"(scl_w), "v"(scl_x)); \
        else { acc[ai][bj][m][n] = __builtin_amdgcn_mfma_f32_16x16x32_bf16(PG8_LO(Bt[n]), PG8_LO(At[m]), acc[ai][bj][m][n], 0, 0, 0); \
               acc[ai][bj][m][n] = __builtin_amdgcn_mfma_f32_16x16x32_bf16(PG8_HI(Bt[n]), PG8_HI(At[m]), acc[ai][bj][m][n], 0, 0, 0); } } \
        __builtin_amdgcn_s_setprio(0); } while (0)
#define PG8_WAIT_V(n) asm volatile("s_waitcnt vmcnt(" #n ")" ::: "memory")
#define PG8_WAIT_L(n) asm volatile("s_waitcnt lgkmcnt(" #n ")" ::: "memory")
#define PG8_BAR __builtin_amdgcn_s_barrier()
#define PG8_SCHED __builtin_amdgcn_sched_barrier(0)
    Unit cur, nxt; int ui = 0;
    if (!S.next(0, cur)) return;
    f32x4 acc[2][2][4][2];
#pragma unroll
    for (int a = 0; a < 2; ++a)
#pragma unroll
        for (int b = 0; b < 2; ++b)
#pragma unroll
            for (int m = 0; m < 4; ++m)
#pragma unroll
                for (int n = 0; n < 2; ++n) acc[a][b][m][n] = (f32x4){0.f, 0.f, 0.f, 0.f};
    i32x8 At[4], B0[2], B1[2];
    int scl_w = 0x7f7f7f7f - W8_SHIFT * 0x01010101, scl_x = 0x7f7f7f7f - g.xshift * 0x01010101; asm volatile("" : "+v"(scl_w), "+v"(scl_x)); (void)scl_w; (void)scl_x;
    const char* cA = (const char*)g.A + (size_t)cur.pm * tstepA; const char* cB = (const char*)g.Bt + (size_t)cur.pn * tstepB;
    PG8_STAGE(PG8_SB(0, 0), cB, voffB); PG8_STAGE(PG8_SB(0, 1), cB + hstepB, voffB); PG8_STAGE(PG8_SA(0, 0), cA, voffA); PG8_STAGE(PG8_SA(0, 1), cA + hstepA, voffA);
    if (wr == 1) PG8_BAR;
    PG8_WAIT_V(2); PG8_BAR;
    PG8_STAGE(PG8_SB(1, 0), cB + kstep, voffB); PG8_STAGE(PG8_SA(1, 0), cA + kstep, voffA); PG8_STAGE(PG8_SB(1, 1), cB + hstepB + kstep, voffB);
    PG8_WAIT_V(6); PG8_BAR;
    for (;;) {
        const bool has_next = S.next(ui + 1, nxt);
        const char* nA = has_next ? (const char*)g.A + (size_t)nxt.pm * tstepA : cA; const char* nB = has_next ? (const char*)g.Bt + (size_t)nxt.pn * tstepB : cB;
        for (int t = 0; t < nt; t += 2) {
            const bool last = (t == nt - 2);
            const char* a1 = cA + (size_t)(t + 1) * kstep;
            const char* a2 = last ? nA : cA + (size_t)(t + 2) * kstep; const char* b2 = last ? nB : cB + (size_t)(t + 2) * kstep;
            const char* a3 = a2 + kstep; const char* b3 = b2 + kstep;
            PG8_LDB(B0, 0, 0); PG8_LDB(B1, 0, 1); PG8_SCHED; PG8_LDA(At, 0, 0); PG8_STAGE(PG8_SA(1, 1), a1 + hstepA, voffA);
            PG8_WAIT_V(8); PG8_WAIT_L(0); PG8_BAR; PG8_MMA(0, 0, At, B0); PG8_MMA(0, 1, At, B1); PG8_BAR; PG8_SCHED;
            PG8_LDA(At, 0, 1); PG8_STAGE(PG8_SB(0, 0), b2, voffB); PG8_STAGE(PG8_SB(0, 1), b2 + hstepB, voffB); PG8_STAGE(PG8_SA(0, 0), a2, voffA);
            PG8_WAIT_V(8); PG8_WAIT_L(0); PG8_BAR; PG8_MMA(1, 0, At, B0); PG8_MMA(1, 1, At, B1); PG8_BAR; PG8_SCHED;
            PG8_LDB(B0, 1, 0); PG8_LDB(B1, 1, 1); PG8_SCHED; PG8_LDA(At, 1, 0); PG8_STAGE(PG8_SA(0, 1), a2 + hstepA, voffA);
            PG8_WAIT_V(8); PG8_WAIT_L(0); PG8_BAR; PG8_MMA(0, 0, At, B0); PG8_MMA(0, 1, At, B1); PG8_BAR; PG8_SCHED;
            PG8_LDA(At, 1, 1); PG8_STAGE(PG8_SB(1, 0), b3, voffB); PG8_STAGE(PG8_SB(1, 1), b3 + hstepB, voffB); PG8_STAGE(PG8_SA(1, 0), a3, voffA);
            PG8_WAIT_V(8); PG8_WAIT_L(0); PG8_BAR; PG8_MMA(1, 0, At, B0); PG8_MMA(1, 1, At, B1); PG8_BAR; PG8_SCHED;
        }
        if (wr == 0) PG8_BAR;
        if constexpr (FP8) asm volatile("s_nop 15\n\ts_nop 15" ::: "memory");
        E(acc, cur, wr, wc, fr, fq);
        if (!has_next) break;
#pragma unroll
        for (int a = 0; a < 2; ++a)
#pragma unroll
            for (int b = 0; b < 2; ++b)
#pragma unroll
                for (int m = 0; m < 4; ++m)
#pragma unroll
                    for (int n = 0; n < 2; ++n) acc[a][b][m][n] = (f32x4){0.f, 0.f, 0.f, 0.f};
        cur = nxt; cA = nA; cB = nB; ++ui;
        if (wr == 1) PG8_BAR;
    }
    PG8_WAIT_V(0);
    PG8_BAR;
#undef PG8_SA
#undef PG8_SB
#undef PG8_STAGE
#undef PG8_LDA
#undef PG8_LDB
#undef PG8_MMA
#undef PG8_LD2
#undef PG8_LO
#undef PG8_HI
#undef PG8_WAIT_V
#undef PG8_WAIT_L
#undef PG8_BAR
#undef PG8_SCHED
}
}

namespace att {
constexpr int D = 128, NW = 8, QBLK = 32, KVBLK = 64;
constexpr float SCALE = 0.088388347648318440f;
constexpr int SHM_V = KVBLK * D * 2, SHM_K = KVBLK * D * 2, SHM_ATTN = 2 * SHM_V + 2 * SHM_K + NW * 64 * 4;
constexpr int NA_TBL_OFF = SHM_ATTN, NA_TBL_PAD = 48, NA_TBL_FLOATS = 48 + 15 * 32 + 96, ATT_LDS = NA_TBL_OFF + NA_TBL_FLOATS * 4;
#define KSWZ(row, colB) ((row) * 256 + ((colB) ^ (((row) & 7) << 4)))
#define SBAR() __builtin_amdgcn_sched_barrier(0)
__device__ __forceinline__ int crow(int r, int hi) { return (r & 3) + 8 * (r >> 2) + 4 * hi; }
__device__ __forceinline__ bf16x8 ld8(const bf16_t* p) { return *reinterpret_cast<const bf16x8*>(p); }

template <int THRV = 8>
__device__ __forceinline__ void partialSM(f32x16& p0, f32x16& p1, float& m_reg, float& mn, float& alpha) {
  constexpr float C = SCALE * 1.4426950408889634f; constexpr float THR = (float)THRV;
  float pmax = p0[0];
#pragma unroll
  for (int r = 1; r < 16; ++r) pmax = fmaxf(pmax, p0[r]);
#pragma unroll
  for (int r = 0; r < 16; ++r) pmax = fmaxf(pmax, p1[r]);
  { auto rr = __builtin_amdgcn_permlane32_swap(__float_as_uint(pmax), __float_as_uint(pmax), false, false);
    pmax = fmaxf(__uint_as_float(rr[0]), __uint_as_float(rr[1])); }
  if (__builtin_expect(__all(pmax - m_reg <= THR / SCALE), 1)) { mn = m_reg; alpha = 1.f; }
  else { mn = fmaxf(m_reg, pmax); alpha = __builtin_amdgcn_exp2f((m_reg - mn) * C); m_reg = mn; }
  float mnC = -mn * C;
#pragma unroll
  for (int r = 0; r < 16; ++r) p0[r] = fmaf(p0[r], C, mnC);
#pragma unroll
  for (int r = 0; r < 16; ++r) p1[r] = fmaf(p1[r], C, mnC);
#pragma unroll
  for (int r = 0; r < 16; ++r) p0[r] = __builtin_amdgcn_exp2f(p0[r]);
}
__device__ __forceinline__ void finishSM(f32x16& p0, f32x16& p1, float alpha, float& l_reg, bf16x8& pa0, bf16x8& pa1, bf16x8& pa2, bf16x8& pa3) {
#pragma unroll
  for (int r = 0; r < 16; ++r) p1[r] = __builtin_amdgcn_exp2f(p1[r]);
  float ps = 0;
#pragma unroll
  for (int r = 0; r < 16; ++r) ps += p0[r];
#pragma unroll
  for (int r = 0; r < 16; ++r) ps += p1[r];
  { auto rr = __builtin_amdgcn_permlane32_swap(__float_as_uint(ps), __float_as_uint(ps), false, false);
    ps = __uint_as_float(rr[0]) + __uint_as_float(rr[1]); }
  l_reg = l_reg * alpha + ps;
#define PK4(P, BASE, OUT) do { unsigned a0 = cvt_pk_bf16(P[BASE + 0], P[BASE + 1]), a1 = cvt_pk_bf16(P[BASE + 2], P[BASE + 3]);   \
    unsigned b0 = cvt_pk_bf16(P[BASE + 4], P[BASE + 5]), b1 = cvt_pk_bf16(P[BASE + 6], P[BASE + 7]);                              \
    auto r0 = __builtin_amdgcn_permlane32_swap(a0, b0, false, false); auto r1 = __builtin_amdgcn_permlane32_swap(a1, b1, false, false); \
    u32x4 w = {r0[0], r1[0], r0[1], r1[1]}; OUT = *reinterpret_cast<bf16x8*>(&w); } while (0)
  PK4(p0, 0, pa0); PK4(p0, 8, pa1); PK4(p1, 0, pa2); PK4(p1, 8, pa3);
#undef PK4
}
__device__ __forceinline__ void qkt(f32x16& p0, f32x16& p1, const bf16_t* Ks, const bf16x8* qr, int r32, int hi) {
  p0 = f32x16{}; p1 = f32x16{};
#pragma unroll
  for (int d0 = 0; d0 < 8; ++d0) { int cb = (d0 * 16 + hi * 8) * 2;
    bf16x8 b0 = *reinterpret_cast<const bf16x8*>((const char*)Ks + KSWZ(r32, cb));
    bf16x8 b1 = *reinterpret_cast<const bf16x8*>((const char*)Ks + KSWZ(32 + r32, cb));
    p0 = __builtin_amdgcn_mfma_f32_32x32x16_bf16(b0, qr[d0], p0, 0, 0, 0);
    p1 = __builtin_amdgcn_mfma_f32_32x32x16_bf16(b1, qr[d0], p1, 0, 0, 0); }
}
__device__ __forceinline__ int v_st(int k, int c) { const int kk = (k & ~0xC) | ((k & 4) << 1) | ((k & 8) >> 1); return ((kk >> 3) * 4 + (c >> 5)) * 512 + ((kk & 7) * 32 + (c & 31)) * 2; }
__device__ __forceinline__ int v_rd_base(int lane) { return ((lane & 3) << 3) | (((lane >> 2) & 3) << 6) | (((lane >> 4) & 1) << 5) | (((lane >> 5) & 1) << 8); }
constexpr int v_rd_off(int d0, int ks, int half) { return d0 * 512 + ks * 4096 + half * 2048; }
template <int OFF> __device__ __forceinline__ s16x4 tr_read(int vb) {
  s16x4 r; asm volatile("ds_read_b64_tr_b16 %0, %1 offset:%2" : "=&v"(r) : "v"(vb), "i"(OFF) : "memory"); return r;
}
template <int D0> __device__ __forceinline__ void pv_one(f32x16& od, int vb, bf16x8 pa0, bf16x8 pa1, bf16x8 pa2, bf16x8 pa3) {
  const s16x4 l0 = tr_read<v_rd_off(D0, 0, 0)>(vb), h0 = tr_read<v_rd_off(D0, 0, 1)>(vb), l1 = tr_read<v_rd_off(D0, 1, 0)>(vb), h1 = tr_read<v_rd_off(D0, 1, 1)>(vb);
  const s16x4 l2 = tr_read<v_rd_off(D0, 2, 0)>(vb), h2 = tr_read<v_rd_off(D0, 2, 1)>(vb), l3 = tr_read<v_rd_off(D0, 3, 0)>(vb), h3 = tr_read<v_rd_off(D0, 3, 1)>(vb);
  asm volatile("s_waitcnt lgkmcnt(0)" ::: "memory"); SBAR();
#define PK(L, H) (bf16x8){L[0], L[1], L[2], L[3], H[0], H[1], H[2], H[3]}
  od = __builtin_amdgcn_mfma_f32_32x32x16_bf16(pa0, PK(l0, h0), od, 0, 0, 0);
  od = __builtin_amdgcn_mfma_f32_32x32x16_bf16(pa1, PK(l1, h1), od, 0, 0, 0);
  od = __builtin_amdgcn_mfma_f32_32x32x16_bf16(pa2, PK(l2, h2), od, 0, 0, 0);
  od = __builtin_amdgcn_mfma_f32_32x32x16_bf16(pa3, PK(l3, h3), od, 0, 0, 0);
#undef PK
}
__device__ __forceinline__ void pv_d0(f32x16* o, int vb, bf16x8 pa0, bf16x8 pa1, bf16x8 pa2, bf16x8 pa3) {
  pv_one<0>(o[0], vb, pa0, pa1, pa2, pa3); pv_one<1>(o[1], vb, pa0, pa1, pa2, pa3); pv_one<2>(o[2], vb, pa0, pa1, pa2, pa3); pv_one<3>(o[3], vb, pa0, pa1, pa2, pa3);
}
struct NaCtx { int r, rs, c, cs, kr0; const LAS float* tbl; };
__device__ __forceinline__ void na_mask(f32x16& p0, f32x16& p1, const NaCtx& n, int tile, int hi) {
  const int kr = n.kr0 + tile; const bool vrow = (kr >= n.rs) && (kr < n.rs + 8);
  int dr = kr - n.r + 7; dr = dr < 0 ? 0 : (dr > 14 ? 14 : dr);
  const LAS float* t = n.tbl + dr * 32 + 15 - n.c;
  const float NEG = -INFINITY;
  const int d0 = 4 * hi - n.cs;
#pragma unroll
  for (int rr = 0; rr < 16; ++rr) { const int kq = (rr & 3) + 8 * (rr >> 2);
    const bool ok0 = vrow && ((unsigned)(kq + d0) < 16u), ok1 = vrow && ((unsigned)(kq + 32 + d0) < 16u);
    const float b0 = t[kq + 4 * hi], b1 = t[kq + 4 * hi + 32];
    p0[rr] = ok0 ? p0[rr] + b0 : NEG; p1[rr] = ok1 ? p1[rr] + b1 : NEG;
    if ((rr & 3) == 3) asm volatile("" ::: "memory"); }
}

template <int LDQ, int LDK, int LDO, bool NA, int OSH = -1>
__device__ __forceinline__ void attn_body(const bf16_t* Qb, const bf16_t* __restrict__ Kh, const bf16_t* __restrict__ Vh, bf16_t* Ob, int seq, char* lds, const NaCtx& na) {
  int tid_ = threadIdx.x; asm volatile("" : "+v"(tid_));
  const int tid = tid_, wid = tid >> 6, lane = tid & 63, r32 = lane & 31, hi = lane >> 5;
  bf16_t* V_lds = (bf16_t*)lds; bf16_t* K_lds = (bf16_t*)(lds + 2 * SHM_V);
  float* ws = (float*)(lds + 2 * SHM_V + 2 * SHM_K) + wid * 64; float* li_l = ws; float* al_l = ws + 32;
  float m_reg = -1e30f, l_reg = 0; f32x16 o[4] = {}; bf16x8 qr[8];
  const bf16_t* Qw = Qb + (long)(wid * QBLK + r32) * LDQ + hi * 8;
#pragma unroll
  for (int d0 = 0; d0 < 8; ++d0) qr[d0] = ld8(Qw + d0 * 16);
  const int sr = tid >> 4, sc = (tid & 15) * 8, vst0 = v_st(sr, sc), vst1 = v_st(32 + sr, sc);
  const int vb0 = (int)(uintptr_t)V_lds + v_rd_base(lane);
  struct { bf16x8 vs0, vs1, ks0, ks1; } sr_[2];
#define SLOAD(i, k0) do { sr_[i].vs0 = ld8(&Vh[(long)((k0) + sr) * LDK + sc]); sr_[i].vs1 = ld8(&Vh[(long)((k0) + 32 + sr) * LDK + sc]); \
    sr_[i].ks0 = ld8(&Kh[(long)((k0) + sr) * LDK + sc]); sr_[i].ks1 = ld8(&Kh[(long)((k0) + 32 + sr) * LDK + sc]); } while (0)
#define SWRITE(b, i) do { *(bf16x8*)((char*)V_lds + (b) * SHM_V + vst0) = sr_[i].vs0;          \
    *(bf16x8*)((char*)V_lds + (b) * SHM_V + vst1) = sr_[i].vs1; int kc = sc * 2;               \
    *(bf16x8*)((char*)K_lds + (b) * SHM_K + KSWZ(sr, kc)) = sr_[i].ks0;                       \
    *(bf16x8*)((char*)K_lds + (b) * SHM_K + KSWZ(32 + sr, kc)) = sr_[i].ks1; } while (0)
#define SWAIT() asm volatile("s_waitcnt vmcnt(4)" ::: "memory")
#define RESC(a) do { if (__any((a) < 1.f)) { if (hi == 0) al_l[r32] = (a); asm volatile("s_waitcnt lgkmcnt(0)" ::: "memory"); \
    _Pragma("unroll") for (int d = 0; d < 4; ++d) _Pragma("unroll") for (int r = 0; r < 16; ++r) o[d][r] *= al_l[crow(r, hi)]; } } while (0)
#define NAM(P0, P1, t) do { if constexpr (NA) { SBAR(); na_mask(P0, P1, na, (t), hi); SBAR(); } } while (0)
  f32x16 pA0, pA1, pB0, pB1; float mnA, mnB, alA, alB; bf16x8 pa0, pa1, pa2, pa3; const int NT = seq / KVBLK;
  constexpr int SE = 0, SO = 1;
  SLOAD(SE, 0); asm volatile("s_waitcnt vmcnt(0)" ::: "memory"); SWRITE(0, SE); __syncthreads();
  qkt(pA0, pA1, K_lds, qr, r32, hi); NAM(pA0, pA1, 0); partialSM(pA0, pA1, m_reg, mnA, alA);
  SLOAD(SO, KVBLK); if (2 < NT) SLOAD(SE, 2 * KVBLK);
  SWAIT(); SWRITE(1, SO); __syncthreads();
  for (int j = 1; j + 1 < NT; j += 2) {
    SBAR(); qkt(pB0, pB1, (bf16_t*)((char*)K_lds + SHM_K), qr, r32, hi);
    finishSM(pA0, pA1, alA, l_reg, pa0, pa1, pa2, pa3); SBAR();
    SLOAD(SO, (j + 2) * KVBLK); SBAR();
    pv_d0(o, vb0, pa0, pa1, pa2, pa3); NAM(pB0, pB1, j); partialSM(pB0, pB1, m_reg, mnB, alB);
    __syncthreads(); SWAIT(); SWRITE(0, SE);
    RESC(alB); __syncthreads();
    SBAR(); qkt(pA0, pA1, K_lds, qr, r32, hi);
    finishSM(pB0, pB1, alB, l_reg, pa0, pa1, pa2, pa3); SBAR();
    if (j + 3 < NT) SLOAD(SE, (j + 3) * KVBLK); SBAR();
    pv_d0(o, vb0 + (int)SHM_V, pa0, pa1, pa2, pa3); NAM(pA0, pA1, j + 1); partialSM(pA0, pA1, m_reg, mnA, alA);
    __syncthreads(); SWAIT(); SWRITE(1, SO);
    RESC(alA); __syncthreads();
  }
  SBAR(); qkt(pB0, pB1, (bf16_t*)((char*)K_lds + SHM_K), qr, r32, hi);
  finishSM(pA0, pA1, alA, l_reg, pa0, pa1, pa2, pa3); SBAR();
  pv_d0(o, vb0, pa0, pa1, pa2, pa3); NAM(pB0, pB1, NT - 1); partialSM(pB0, pB1, m_reg, mnB, alB);
  __syncthreads(); RESC(alB);
  finishSM(pB0, pB1, alB, l_reg, pa0, pa1, pa2, pa3); SBAR();
  pv_d0(o, vb0 + (int)SHM_V, pa0, pa1, pa2, pa3);
  if (hi == 0) li_l[r32] = l_reg; asm volatile("s_waitcnt lgkmcnt(0)" ::: "memory");
  float rli[16];
#pragma unroll
  for (int r = 0; r < 16; ++r) rli[r] = __builtin_amdgcn_rcpf(li_l[crow(r, hi)]);
  if constexpr (OSH >= 0) {
    unsigned char* Ow8 = (unsigned char*)Ob + (long)(wid * QBLK) * LDO;
#pragma unroll
    for (int r = 0; r < 16; ++r) { int orow = crow(r, hi); const float sc = rli[r] * (float)(1 << (OSH >= 0 ? OSH : 0));
#pragma unroll
      for (int d0 = 0; d0 < 4; ++d0) Ow8[(long)orow * LDO + d0 * 32 + r32] = (unsigned char)(__builtin_amdgcn_cvt_pk_fp8_f32(o[d0][r] * sc, 0.f, 0, false) & 0xff); }
  } else {
  bf16_t* Ow = Ob + (long)(wid * QBLK) * LDO;
#pragma unroll
  for (int r = 0; r < 16; ++r) { int orow = crow(r, hi);
#pragma unroll
    for (int d0 = 0; d0 < 4; ++d0) Ow[(long)orow * LDO + d0 * 32 + r32] = (bf16_t)(cvt_pk_bf16(o[d0][r] * rli[r], 0.f) & 0xffffu); }
  }
#undef SLOAD
#undef SWRITE
#undef SWAIT
#undef RESC
#undef NAM
}

__device__ __forceinline__ int vt_pos(int l) { const int kk = l & 31; return 32 * ((l >> 2) & 1) + (kk & 3) + 4 * (kk >> 3) + 16 * (l >> 5); }
#define F8_MFMA(A, B, C) __builtin_amdgcn_mfma_scale_f32_32x32x64_f8f6f4(A, B, C, 0, 0, 0, 0x7f7f7f7f, 0, 0x7f7f7f7f)
#define F8_MFMA_QK(A, B, C) __builtin_amdgcn_mfma_scale_f32_32x32x64_f8f6f4(A, B, C, 0, 0, 0, 0x7f7f7f7f, 0, 0x7c7c7c7c)
constexpr float QPRE = SCALE * 1.4426950408889634f * 8.0f;
template <int THRV>
__device__ __forceinline__ void partialSM8(f32x16& p0, f32x16& p1, float& m_reg, float& mn, float& alpha) {
  constexpr float THR2 = (float)THRV * 1.4426950408889634f;
  float pmax = p0[0];
#pragma unroll
  for (int r = 1; r < 16; ++r) pmax = fmaxf(pmax, p0[r]);
#pragma unroll
  for (int r = 0; r < 16; ++r) pmax = fmaxf(pmax, p1[r]);
  { auto rr = __builtin_amdgcn_permlane32_swap(__float_as_uint(pmax), __float_as_uint(pmax), false, false);
    pmax = fmaxf(__uint_as_float(rr[0]), __uint_as_float(rr[1])); }
  if (__builtin_expect(__all(pmax - m_reg <= THR2), 1)) { mn = m_reg; alpha = 1.f; }
  else { mn = fmaxf(m_reg, pmax); alpha = __builtin_amdgcn_exp2f(m_reg - mn); m_reg = mn; }
  p0 = p0 - mn; p1 = p1 - mn;
#pragma unroll
  for (int r = 0; r < 16; ++r) p0[r] = __builtin_amdgcn_exp2f(p0[r]);
}
#define F8_CAT(lo, hi) __builtin_shufflevector(lo, hi, 0, 1, 2, 3, 4, 5, 6, 7)
__device__ __forceinline__ void qkt8(f32x16& p0, f32x16& p1, const char* Ks, const i32x8* q8, int r32, int hi) {
  const int g = (r32 >> 1) & 7;
  const char* k0 = Ks + r32 * 128; const char* k1 = k0 + 32 * 128;
#pragma unroll
  for (int j = 0; j < 2; ++j) { const int c0 = 4 * j + 2 * hi;
    const i32x8 a0 = F8_CAT(*(const i32x4*)(k0 + (((c0) ^ g) << 4)), *(const i32x4*)(k0 + (((c0 + 1) ^ g) << 4)));
    const i32x8 a1 = F8_CAT(*(const i32x4*)(k1 + (((c0) ^ g) << 4)), *(const i32x4*)(k1 + (((c0 + 1) ^ g) << 4)));
    if (j == 0) { p0 = F8_MFMA_QK(a0, q8[0], f32x16{}); p1 = F8_MFMA_QK(a1, q8[0], f32x16{}); }
    else { p0 = F8_MFMA_QK(a0, q8[1], p0); p1 = F8_MFMA_QK(a1, q8[1], p1); } }
}
__device__ __forceinline__ void pv8(f32x16* o, const char* Vs, i32x8 pa, int r32, int hi) {
#pragma unroll
  for (int db = 0; db < 4; ++db) { const int d = 32 * db + r32, f = (d >> 2) & 3; const char* vr = Vs + d * 64;
    const i32x8 b = F8_CAT(*(const i32x4*)(vr + (((2 * hi) ^ f) << 4)), *(const i32x4*)(vr + (((2 * hi + 1) ^ f) << 4)));
    o[db] = F8_MFMA(pa, b, o[db]); }
}
__device__ __forceinline__ void finishSM8(f32x16& p0, f32x16& p1, float alpha, float& l_reg, i32x8& pa) {
#pragma unroll
  for (int r = 0; r < 16; ++r) p1[r] = __builtin_amdgcn_exp2f(p1[r]);
  float ps;
  { typedef float f32x8_ __attribute__((ext_vector_type(8)));
    const f32x16 t = p0 + p1;
    const f32x8_ t8 = __builtin_shufflevector(t, t, 0, 1, 2, 3, 4, 5, 6, 7) + __builtin_shufflevector(t, t, 8, 9, 10, 11, 12, 13, 14, 15);
    const f32x4 t4 = __builtin_shufflevector(t8, t8, 0, 1, 2, 3) + __builtin_shufflevector(t8, t8, 4, 5, 6, 7);
    const f32x2 t2 = __builtin_shufflevector(t4, t4, 0, 1) + __builtin_shufflevector(t4, t4, 2, 3);
    ps = t2.x + t2.y; }
  { auto rr = __builtin_amdgcn_permlane32_swap(__float_as_uint(ps), __float_as_uint(ps), false, false);
    ps = __uint_as_float(rr[0]) + __uint_as_float(rr[1]); }
  l_reg = l_reg * alpha + ps;
#pragma unroll
  for (int w = 0; w < 4; ++w) { pa[w] = (int)pack4_fp8(p0[4 * w], p0[4 * w + 1], p0[4 * w + 2], p0[4 * w + 3]); pa[4 + w] = (int)pack4_fp8(p1[4 * w], p1[4 * w + 1], p1[4 * w + 2], p1[4 * w + 3]); }
}
constexpr int F8_KB = 8192, F8_LDS_V = 2 * F8_KB, F8_LDS_WS = 4 * F8_KB;
template <int LDQ, int LDK, int LDO, int OSH>
__device__ __forceinline__ void attn_body_f8(const unsigned char* Qb, const unsigned char* __restrict__ Kh, const unsigned char* __restrict__ VTh, long ldv, unsigned char* Ob, int seq, char* lds) {
  int tid_ = threadIdx.x; asm volatile("" : "+v"(tid_));
  const int tid = tid_, wid = tid >> 6, lane = tid & 63, r32 = lane & 31, hi = lane >> 5;
  char* K_lds = lds; char* V_lds = lds + F8_LDS_V;
  float* ws = (float*)(lds + F8_LDS_WS) + wid * 64; float* li_l = ws; float* al_l = ws + 32;
  float m_reg = -1e30f, l_reg = 0; f32x16 o[4] = {}; i32x8 q8[2];
  { const unsigned char* Qw = Qb + (long)(wid * QBLK + r32) * LDQ + 32 * hi;
#pragma unroll
    for (int j = 0; j < 2; ++j) q8[j] = F8_CAT(*(const i32x4*)(Qw + 64 * j), *(const i32x4*)(Qw + 64 * j + 16)); }
  const int krow = tid >> 3, kc = tid & 7, kst = krow * 128 + ((kc ^ ((krow >> 1) & 7)) << 4);
  const int vd = tid >> 2, vc = tid & 3, vst = vd * 64 + ((vc ^ ((vd >> 2) & 3)) << 4);
  const unsigned char* kg = Kh + (long)krow * LDK + 16 * kc; const unsigned char* vg = VTh + (long)vd * ldv + 16 * vc;
  struct { i32x4 ks, vs; } sr_[2];
#define SLOAD(i, k0) do { sr_[i].ks = *(const i32x4*)(kg + (long)(k0) * LDK); sr_[i].vs = *(const i32x4*)(vg + (k0)); } while (0)
#define SWRITE(b, i) do { *(i32x4*)(K_lds + (b) * F8_KB + kst) = sr_[i].ks; *(i32x4*)(V_lds + (b) * F8_KB + vst) = sr_[i].vs; } while (0)
#define SWAIT() asm volatile("s_waitcnt vmcnt(2)" ::: "memory")
#define RESC(a) do { if (__any((a) < 1.f)) { if (hi == 0) al_l[r32] = (a); asm volatile("s_waitcnt lgkmcnt(0)" ::: "memory"); \
    _Pragma("unroll") for (int d = 0; d < 4; ++d) _Pragma("unroll") for (int r = 0; r < 16; ++r) o[d][r] *= al_l[crow(r, hi)]; } } while (0)
#define PV8(b, pa) do { asm volatile("s_waitcnt lgkmcnt(0)" ::: "memory"); pv8(o, V_lds + (b) * F8_KB, pa, r32, hi); } while (0)
  f32x16 pA0, pA1, pB0, pB1; float mnA, mnB, alA, alB; i32x8 pa; const int NT = seq / KVBLK;
  if (wid >= 4) __builtin_amdgcn_s_setprio(1);
  constexpr int SE = 0, SO = 1;
  SLOAD(SE, 0); asm volatile("s_waitcnt vmcnt(0)" ::: "memory"); SWRITE(0, SE); __syncthreads();
  qkt8(pA0, pA1, K_lds, q8, r32, hi); partialSM8<5>(pA0, pA1, m_reg, mnA, alA);
  SLOAD(SO, KVBLK); if (2 < NT) SLOAD(SE, 2 * KVBLK);
  SWAIT(); SWRITE(1, SO); __syncthreads();
  for (int j = 1; j + 1 < NT; j += 2) {
    SBAR(); qkt8(pB0, pB1, K_lds + F8_KB, q8, r32, hi);
    finishSM8(pA0, pA1, alA, l_reg, pa); SBAR();
    SLOAD(SO, (j + 2) * KVBLK); SBAR();
    PV8(0, pa); partialSM8<5>(pB0, pB1, m_reg, mnB, alB);
    __syncthreads(); SWAIT(); SWRITE(0, SE);
    RESC(alB); __syncthreads();
    SBAR(); qkt8(pA0, pA1, K_lds, q8, r32, hi);
    finishSM8(pB0, pB1, alB, l_reg, pa); SBAR();
    if (j + 3 < NT) SLOAD(SE, (j + 3) * KVBLK); SBAR();
    PV8(1, pa); partialSM8<5>(pA0, pA1, m_reg, mnA, alA);
    __syncthreads(); SWAIT(); SWRITE(1, SO);
    RESC(alA); __syncthreads();
  }
  SBAR(); qkt8(pB0, pB1, K_lds + F8_KB, q8, r32, hi);
  finishSM8(pA0, pA1, alA, l_reg, pa); SBAR();
  PV8(0, pa); partialSM8<5>(pB0, pB1, m_reg, mnB, alB);
  __syncthreads(); RESC(alB);
  finishSM8(pB0, pB1, alB, l_reg, pa); SBAR();
  PV8(1, pa);
  if (hi == 0) li_l[r32] = l_reg; asm volatile("s_waitcnt lgkmcnt(0)" ::: "memory");
  float rli[16];
#pragma unroll
  for (int r = 0; r < 16; ++r) rli[r] = __builtin_amdgcn_rcpf(li_l[crow(r, hi)]);
  unsigned char* Ow8 = Ob + (long)(wid * QBLK) * LDO;
#pragma unroll
  for (int r = 0; r < 16; ++r) { int orow = crow(r, hi); const float sc = rli[r] * (float)(1 << OSH);
#pragma unroll
    for (int d0 = 0; d0 < 4; ++d0) Ow8[(long)orow * LDO + d0 * 32 + r32] = (unsigned char)(__builtin_amdgcn_cvt_pk_fp8_f32(o[d0][r] * sc, 0.f, 0, false) & 0xff); }
  __builtin_amdgcn_s_setprio(0);
#undef SLOAD
#undef SWRITE
#undef SWAIT
#undef RESC
#undef PV8
}
#undef F8_MFMA
#undef F8_MFMA_QK
#undef F8_CAT
#undef SBAR
}

constexpr int NWAVES = 8;
constexpr int LDS_BYTES = 135168;
static_assert(att::ATT_LDS <= LDS_BYTES && pg8::STAGE_BYTES <= LDS_BYTES, "LDS map");
constexpr int NPH = 1 + 5 * NCH + 3 + 2 * NCH + 1;

struct Args { const float* in[21]; float* out; unsigned char* ws; int ph_lo, ph_hi; };

__device__ __forceinline__ float wave_sum(float v) {
#pragma unroll
    for (int o = 1; o < 64; o <<= 1) v += __shfl_xor(v, o);
    return v;
}
__device__ __forceinline__ void transpose_item(const float* __restrict__ W, int K, int N, bf16_t* __restrict__ WT, const float* __restrict__ gain, LAS float* scr, int item, int lane) {
    const int nblk = N / 32, kb = item / nblk, nb = item % nblk, k0 = 64 * kb, n0 = 32 * nb;
    { const int kr = lane >> 3, n4 = (lane & 7) * 4; f32x4 w[8];
#pragma unroll
      for (int i = 0; i < 8; ++i) w[i] = *(const f32x4*)(W + (size_t)(k0 + 8 * i + kr) * N + n0 + n4);
#pragma unroll
      for (int i = 0; i < 8; ++i) { const int kk = 8 * i + kr; f32x4 v = w[i]; if (gain) v = v * gain[k0 + kk]; LAS float* d = scr + kk * 33 + n4; d[0] = v.x; d[1] = v.y; d[2] = v.z; d[3] = v.w; } }
    asm volatile("s_waitcnt lgkmcnt(0)" ::: "memory");
    const int c = lane & 7;
#pragma unroll
    for (int j = 0; j < 4; ++j) { const int n = (lane >> 3) + 8 * j; const LAS float* s = scr + (8 * c) * 33 + n;
        u32x4 o; o.x = cvt_pk_bf16(s[0 * 33], s[1 * 33]); o.y = cvt_pk_bf16(s[2 * 33], s[3 * 33]); o.z = cvt_pk_bf16(s[4 * 33], s[5 * 33]); o.w = cvt_pk_bf16(s[6 * 33], s[7 * 33]);
        *(u32x4*)(WT + (size_t)(n0 + n) * K + k0 + 8 * c) = o; }
    asm volatile("s_waitcnt lgkmcnt(0)" ::: "memory");
}
__device__ __forceinline__ void transpose_item_fp8(const float* __restrict__ W, int K, int N, unsigned char* __restrict__ WT, const float* __restrict__ gain, float mul, LAS float* scr, int item, int lane) {
    const int nblk = N / 32, kb = item / nblk, nb = item % nblk, k0 = 64 * kb, n0 = 32 * nb;
    { const int kr = lane >> 3, n4 = (lane & 7) * 4; f32x4 w[8];
#pragma unroll
      for (int i = 0; i < 8; ++i) w[i] = *(const f32x4*)(W + (size_t)(k0 + 8 * i + kr) * N + n0 + n4);
#pragma unroll
      for (int i = 0; i < 8; ++i) { const int kk = 8 * i + kr; f32x4 v = w[i] * mul; if (gain) v = v * gain[k0 + kk]; LAS float* d = scr + kk * 33 + n4; d[0] = v.x; d[1] = v.y; d[2] = v.z; d[3] = v.w; } }
    asm volatile("s_waitcnt lgkmcnt(0)" ::: "memory");
    const int c = lane & 3;
#pragma unroll
    for (int j = 0; j < 2; ++j) { const int n = (lane >> 2) + 16 * j; const LAS float* s = scr + (16 * c) * 33 + n;
        u32x4 o; o.x = pack4_fp8(s[0 * 33], s[1 * 33], s[2 * 33], s[3 * 33]); o.y = pack4_fp8(s[4 * 33], s[5 * 33], s[6 * 33], s[7 * 33]);
        o.z = pack4_fp8(s[8 * 33], s[9 * 33], s[10 * 33], s[11 * 33]); o.w = pack4_fp8(s[12 * 33], s[13 * 33], s[14 * 33], s[15 * 33]);
        *(u32x4*)(WT + (size_t)(n0 + n) * K + k0 + 16 * c) = o; }
    asm volatile("s_waitcnt lgkmcnt(0)" ::: "memory");
}
__device__ __forceinline__ void rms_row_to_fp8(const float* xrow, unsigned char* orow, int lane) {
    const f32x4* xr = (const f32x4*)xrow + lane;
    f32x4 v[8]; float s = 0.f;
#pragma unroll
    for (int j = 0; j < 8; ++j) { v[j] = xr[64 * j]; s += (v[j].x * v[j].x + v[j].y * v[j].y) + (v[j].z * v[j].z + v[j].w * v[j].w); }
    const float rr = __builtin_amdgcn_rsqf(wave_sum(s) * (1.f / DM) + EPS);
    unsigned* o4 = (unsigned*)orow + lane;
#pragma unroll
    for (int j = 0; j < 8; ++j) o4[64 * j] = pack4_fp8(v[j].x * rr, v[j].y * rr, v[j].z * rr, v[j].w * rr);
}
__device__ __forceinline__ void rms_row2_to_fp8(const float* xa, const float* xb, unsigned char* oa, unsigned char* ob, int lane) {
    const f32x4* pa = (const f32x4*)xa + lane; const f32x4* pb = (const f32x4*)xb + lane;
    f32x4 va[8], vb[8]; float sa = 0.f, sb = 0.f;
#pragma unroll
    for (int j = 0; j < 8; ++j) { va[j] = pa[64 * j]; vb[j] = pb[64 * j]; }
#pragma unroll
    for (int j = 0; j < 8; ++j) { sa += (va[j].x * va[j].x + va[j].y * va[j].y) + (va[j].z * va[j].z + va[j].w * va[j].w); sb += (vb[j].x * vb[j].x + vb[j].y * vb[j].y) + (vb[j].z * vb[j].z + vb[j].w * vb[j].w); }
    const float ra = __builtin_amdgcn_rsqf(wave_sum(sa) * (1.f / DM) + EPS), rb = __builtin_amdgcn_rsqf(wave_sum(sb) * (1.f / DM) + EPS);
    unsigned* qa = (unsigned*)oa + lane; unsigned* qb = (unsigned*)ob + lane;
#pragma unroll
    for (int j = 0; j < 8; ++j) { qa[64 * j] = pack4_fp8(va[j].x * ra, va[j].y * ra, va[j].z * ra, va[j].w * ra); qb[64 * j] = pack4_fp8(vb[j].x * rb, vb[j].y * rb, vb[j].z * rb, vb[j].w * rb); }
}
__device__ __forceinline__ void rms_row_to_bf16(const float* xrow, bf16_t* orow, int lane) {
    const f32x4* xr = (const f32x4*)xrow + lane;
    f32x4 v[8]; float s = 0.f;
#pragma unroll
    for (int j = 0; j < 8; ++j) { v[j] = xr[64 * j]; s += (v[j].x * v[j].x + v[j].y * v[j].y) + (v[j].z * v[j].z + v[j].w * v[j].w); }
    const float rr = __builtin_amdgcn_rsqf(wave_sum(s) * (1.f / DM) + EPS);
    u32x2* o8 = (u32x2*)orow + lane;
#pragma unroll
    for (int j = 0; j < 8; ++j) { u32x2 w; w.x = cvt_pk_bf16(v[j].x * rr, v[j].y * rr); w.y = cvt_pk_bf16(v[j].z * rr, v[j].w * rr); o8[64 * j] = w; }
}
__device__ __forceinline__ u32x4 rope_item(const u32x4 raw, const size_t e0, int W, int seq, const float* __restrict__ g, float mul) {
    const int tok = (int)(e0 / (size_t)W), d = (int)(e0 & 127);
    float x[8] = {bf_lo(raw.x), bf_hi(raw.x), bf_lo(raw.y), bf_hi(raw.y), bf_lo(raw.z), bf_hi(raw.z), bf_lo(raw.w), bf_hi(raw.w)};
    float ssq = 0.f;
#pragma unroll
    for (int e = 0; e < 8; ++e) ssq += x[e] * x[e];
    ssq += __shfl_xor(ssq, 1); ssq += __shfl_xor(ssq, 2); ssq += __shfl_xor(ssq, 4); ssq += __shfl_xor(ssq, 8);
    const float rr = __builtin_amdgcn_rsqf(ssq * (1.f / 128.f) + EPS);
    const f32x4 g0 = *(const f32x4*)(g + d), g1 = *(const f32x4*)(g + d + 4);
    x[0] *= rr * g0.x; x[1] *= rr * g0.y; x[2] *= rr * g0.z; x[3] *= rr * g0.w; x[4] *= rr * g1.x; x[5] *= rr * g1.y; x[6] *= rr * g1.z; x[7] *= rr * g1.w;
    const int s = tok % seq; const float pos = (float)((d < 64) ? (s >> 6) : (s & 63));
    const bool first = ((d & 63) < 32); const int fi0 = d & 31;
    float y[8];
#pragma unroll
    for (int e = 0; e < 8; ++e) { const float other = __shfl_xor(x[e], 4);
        const float invf = __builtin_amdgcn_exp2f(-(float)(fi0 + e) * 0.41524101186092029f);
        float rev = pos * invf * 0.15915494309189535f; rev -= rintf(rev);
        const float sn = __builtin_amdgcn_sinf(rev), cs = __builtin_amdgcn_cosf(rev);
        y[e] = (first ? (x[e] * cs - other * sn) : (x[e] * cs + other * sn)) * mul; }
    u32x4 w; w.x = pack4_fp8(y[0], y[1], y[2], y[3]); w.y = pack4_fp8(y[4], y[5], y[6], y[7]); w.z = 0u; w.w = 0u;
    return w;
}
__device__ __forceinline__ void rope_pass(const bf16_t* buf, unsigned char* out8, int W, int ntok, int seq, const float* __restrict__ g, float mul, int gw, int ngw, int lane) {
    const int nitems = (int)(((size_t)ntok * W) / 512);
    for (int it = gw; it < nitems; it += 4 * ngw) {
        size_t e[4]; u32x4 raw[4];
#pragma unroll
        for (int q = 0; q < 4; ++q) { const int iq = it + q * ngw; e[q] = (size_t)(iq < nitems ? iq : it) * 512 + (size_t)lane * 8; raw[q] = *(const u32x4*)(buf + e[q]); }
#pragma unroll
        for (int q = 0; q < 4; ++q) { const u32x4 w = rope_item(raw[q], e[q], W, seq, g, mul); if (it + q * ngw < nitems) { u32x2 o; o.x = w.x; o.y = w.y; *(u32x2*)(out8 + e[q]) = o; } }
    }
}
__device__ __forceinline__ void vt_pass(const bf16_t* gv, unsigned char* VT8, int ntok, int seq, int gw, int ngw, int lane) {
    const int nitems = (ntok / 64) * 2;
    for (int it = gw; it < nitems; it += ngw) {
        const int blk = it >> 1, kvh = it & 1, tok0 = blk * 64, b = tok0 / seq, s0 = tok0 % seq;
        const bf16_t* src = gv + (size_t)(tok0 + lane) * 256 + kvh * 128;
        unsigned char* dst = VT8 + ((size_t)(b * 2 + kvh) * 128) * (size_t)seq + s0 + att::vt_pos(lane);
        u32x4 raw[16];
#pragma unroll
        for (int c = 0; c < 16; ++c) raw[c] = *(const u32x4*)(src + 8 * c);
#pragma unroll
        for (int c = 0; c < 16; ++c) {
            const unsigned a = pack4_fp8(bf_lo(raw[c].x), bf_hi(raw[c].x), bf_lo(raw[c].y), bf_hi(raw[c].y)), d2 = pack4_fp8(bf_lo(raw[c].z), bf_hi(raw[c].z), bf_lo(raw[c].w), bf_hi(raw[c].w));
            unsigned char* dp = dst + (size_t)(8 * c) * seq;
            dp[0] = (unsigned char)(a & 0xff); dp[(size_t)seq] = (unsigned char)((a >> 8) & 0xff); dp[2 * (size_t)seq] = (unsigned char)((a >> 16) & 0xff); dp[3 * (size_t)seq] = (unsigned char)(a >> 24);
            dp[4 * (size_t)seq] = (unsigned char)(d2 & 0xff); dp[5 * (size_t)seq] = (unsigned char)((d2 >> 8) & 0xff); dp[6 * (size_t)seq] = (unsigned char)((d2 >> 16) & 0xff); dp[7 * (size_t)seq] = (unsigned char)(d2 >> 24); }
    }
}

#define XB_TMO      128
#define XB_XCNT(j)  (256  + 64 * (j))
#define XB_XSUB(j)  (1280 + 64 * (j))
#define XB_XGEN(j)  (2304 + 64 * (j))
#define XB_TOP      3328
#define XB_TOPGEN   3392
#define XCD_BAR_WORDS 3456
#define XB_SPIN_CAP (1u << 20)
__device__ __forceinline__ unsigned xb_ld(unsigned* p)              { return __hip_atomic_load(p, __ATOMIC_RELAXED, __HIP_MEMORY_SCOPE_AGENT); }
__device__ __forceinline__ unsigned xb_add(unsigned* p, unsigned v) { return __hip_atomic_fetch_add(p, v, __ATOMIC_RELAXED, __HIP_MEMORY_SCOPE_AGENT); }
__device__ __forceinline__ unsigned xb_xcc_id() { return (unsigned)__builtin_amdgcn_s_getreg((3 << 11) | 20) & 0xFu; }
#define XB_SPIN(cond, bar) do { unsigned _sp = 0; while (cond) { __builtin_amdgcn_s_sleep(1); \
    if ((++_sp & 255u) == 0u) { if (xb_ld(&(bar)[XB_TMO])) break; if (_sp > XB_SPIN_CAP) { atomicAdd(&(bar)[XB_TMO], 1u); break; } } } } while (0)
struct XcdBarrier { unsigned* bar; unsigned x; volatile LAS unsigned* st; };
__device__ __forceinline__ XcdBarrier xcd_barrier_post(unsigned* bar, volatile LAS unsigned* st) {
    XcdBarrier b; b.bar = bar; b.x = xb_xcc_id(); b.st = st;
    if (threadIdx.x == 0) (void)xb_add(&bar[XB_XCNT(b.x)], 1u);
    return b;
}
__device__ __forceinline__ void xcd_barrier_complete(unsigned* bar, unsigned x, unsigned& nloc, unsigned& nx) {
    const unsigned G = gridDim.x * gridDim.y * gridDim.z;
    unsigned sum, cnt, mine, sp = 0u;
    for (;;) {
        sum = 0u; cnt = 0u; mine = 0u;
#pragma unroll
        for (unsigned j = 0; j < 16; ++j) { const unsigned c = xb_ld(&bar[XB_XCNT(j)]); sum += c; cnt += (c > 0u) ? 1u : 0u; mine = (j == x) ? c : mine; }
        if (sum == G) break;
        __builtin_amdgcn_s_sleep(1);
        if ((++sp & 255u) == 0u) { if (xb_ld(&bar[XB_TMO])) break; if (sp > XB_SPIN_CAP) { atomicAdd(&bar[XB_TMO], 1u); break; } }
    }
    nloc = mine > 0u ? mine : 1u; nx = cnt > 0u ? cnt : 1u;
}
__device__ __forceinline__ void xcd_barrier(const XcdBarrier& b) {
    asm volatile("s_waitcnt vmcnt(0)" ::: "memory");
    __syncthreads();
    if (threadIdx.x == 0) {
        unsigned* bar = b.bar;
        __builtin_amdgcn_s_waitcnt(0);
        unsigned nloc = b.st[0], nx = b.st[1];
        if (nloc == 0u) { xcd_barrier_complete(bar, b.x, nloc, nx); b.st[0] = nloc; b.st[1] = nx; }
        const unsigned old = xb_add(&bar[XB_XSUB(b.x)], 1u);
        const unsigned gen = old / nloc;
        if (old + 1u == (gen + 1u) * nloc) {
            __builtin_amdgcn_fence(__ATOMIC_RELEASE, "agent");
            asm volatile("s_waitcnt vmcnt(0)" ::: "memory");
            const unsigned og = xb_add(&bar[XB_TOP], 1u);
            const unsigned tg = og / nx;
            if (og + 1u == (tg + 1u) * nx) xb_add(&bar[XB_TOPGEN], 1u);
            else XB_SPIN(xb_ld(&bar[XB_TOPGEN]) == tg, bar);
            __builtin_amdgcn_fence(__ATOMIC_ACQUIRE, "agent");
            xb_add(&bar[XB_XGEN(b.x)], 1u);
            asm volatile("s_waitcnt vmcnt(0)" ::: "memory");
        } else {
            XB_SPIN(xb_ld(&bar[XB_XGEN(b.x)]) == gen, bar);
            __builtin_amdgcn_fence(__ATOMIC_ACQUIRE, "agent");
            asm volatile("s_waitcnt vmcnt(0)" ::: "memory");
        }
    }
    __syncthreads();
}
constexpr size_t WS_BAR = 655360;
constexpr int LDS_MISC_OFF = 131072 + 2048;
static_assert(WS_BAR >= 3 * (size_t)NTOK * 4 && WS_BAR + XCD_BAR_WORDS * 4 <= WS_WIN && LDS_MISC_OFF + 16 <= LDS_BYTES, "barrier words");
__device__ __forceinline__ void ti_set(const float*& t_src, int& t_ldw, int& t_K, int& t_k0, int& t_n0, int& t_kind, const float*& t_gain, float& t_mul, unsigned char*& t_dst, const float* W, int K, int N, void* WT, const float* gain, float mul, int kind, int r) {
    const int nblk = N / 32, kb = r / nblk, nb = r % nblk; t_src = W; t_ldw = N; t_K = K; t_k0 = 64 * kb; t_n0 = 32 * nb; t_kind = kind; t_gain = gain; t_mul = mul; t_dst = (unsigned char*)WT;
}
__device__ __forceinline__ void ti_load(f32x4 (&t_w)[8], const float* t_src, int t_ldw, int t_k0, int t_n0, int lane) {
    const int kr = lane >> 3, n4 = (lane & 7) * 4;
#pragma unroll
    for (int i = 0; i < 8; ++i) t_w[i] = *(const f32x4*)(t_src + (size_t)(t_k0 + 8 * i + kr) * t_ldw + t_n0 + n4);
}
__device__ __forceinline__ void ti_process(const f32x4 (&t_w)[8], int t_K, int t_k0, int t_n0, int t_kind, const float* t_gain, float t_mul, unsigned char* t_dst, LAS float* scr, int lane) {
    { const int kr = lane >> 3, n4 = (lane & 7) * 4;
#pragma unroll
      for (int i = 0; i < 8; ++i) { const int kk = 8 * i + kr; f32x4 v = t_w[i] * t_mul; if (t_gain) v = v * t_gain[t_k0 + kk]; LAS float* d = scr + kk * 33 + n4; d[0] = v.x; d[1] = v.y; d[2] = v.z; d[3] = v.w; } }
    asm volatile("s_waitcnt lgkmcnt(0)" ::: "memory");
    if (t_kind == 0) { const int c = lane & 7;
#pragma unroll
        for (int j = 0; j < 4; ++j) { const int n = (lane >> 3) + 8 * j; const LAS float* sp = scr + (8 * c) * 33 + n;
            u32x4 o; o.x = cvt_pk_bf16(sp[0 * 33], sp[1 * 33]); o.y = cvt_pk_bf16(sp[2 * 33], sp[3 * 33]); o.z = cvt_pk_bf16(sp[4 * 33], sp[5 * 33]); o.w = cvt_pk_bf16(sp[6 * 33], sp[7 * 33]);
            *(u32x4*)((bf16_t*)t_dst + (size_t)(t_n0 + n) * t_K + t_k0 + 8 * c) = o; } }
    else { const int c = lane & 3;
#pragma unroll
        for (int j = 0; j < 2; ++j) { const int n = (lane >> 2) + 16 * j; const LAS float* sp = scr + (16 * c) * 33 + n;
            u32x4 o; o.x = pack4_fp8(sp[0 * 33], sp[1 * 33], sp[2 * 33], sp[3 * 33]); o.y = pack4_fp8(sp[4 * 33], sp[5 * 33], sp[6 * 33], sp[7 * 33]);
            o.z = pack4_fp8(sp[8 * 33], sp[9 * 33], sp[10 * 33], sp[11 * 33]); o.w = pack4_fp8(sp[12 * 33], sp[13 * 33], sp[14 * 33], sp[15 * 33]);
            *(u32x4*)(t_dst + (size_t)(t_n0 + n) * t_K + t_k0 + 16 * c) = o; } }
    asm volatile("s_waitcnt lgkmcnt(0)" ::: "memory");
}
#define AS4 __attribute__((address_space(4)))
#define PP const AS4 Args* ap = (const AS4 Args*)__builtin_amdgcn_kernarg_segment_ptr(); asm volatile("" : "+s"(ap)); \
    int tid_o = threadIdx.x; asm volatile("" : "+v"(tid_o)); const int tid = tid_o, lane = tid & 63; (void)tid; (void)lane; \
    unsigned char* ws = ap->ws; float* out = ap->out; (void)out; \
    float* ss1 = (float*)(ws + WS_SS); float* ss2 = ss1 + NTOK; float* ss3 = ss2 + NTOK; (void)ss1; (void)ss2; (void)ss3; \
    bf16_t* Win_t = (bf16_t*)(ws + WS_WIN); bf16_t* Wpa_t = (bf16_t*)(ws + WS_WPA); bf16_t* Wpb_t = (bf16_t*)(ws + WS_WPB); bf16_t* Wo_t = (bf16_t*)(ws + WS_WO); \
    bf16_t* Wcq_t = (bf16_t*)(ws + WS_WCQ); bf16_t* Wckv_t = (bf16_t*)(ws + WS_WCKV); bf16_t* Wco_t = (bf16_t*)(ws + WS_WCO); \
    bf16_t* Wup_t = (bf16_t*)(ws + WS_WUP); bf16_t* Wdn_t = (bf16_t*)(ws + WS_WDN); \
    bf16_t* memn = (bf16_t*)(ws + WS_MEMN); bf16_t* memkv = (bf16_t*)(ws + WS_MEMKV); \
    bf16_t* XB = (bf16_t*)(ws + WS_XB); bf16_t* QC = (bf16_t*)(ws + WS_QC); bf16_t* Z = (bf16_t*)(ws + WS_Z); bf16_t* HB = (bf16_t*)(ws + WS_Z); unsigned char* XN8 = ws + WS_XN8; unsigned char* Win8 = ws + WS_WIN; (void)XN8; (void)Win8; \
    unsigned char* Q8 = ws + WS_QC; unsigned char* K8 = ws + WS_QC + 32 * MiB; unsigned char* VT8 = ws + WS_QC + 40 * MiB; (void)Q8; (void)K8; (void)VT8; \
    unsigned char* O8A = ws + WS_O8A; unsigned char* O8B = ws + WS_O8B; unsigned char* M8 = (unsigned char*)(Z + Z_NAK); (void)O8A; (void)O8B; (void)M8; \
    (void)Win_t; (void)Wpa_t; (void)Wpb_t; (void)Wo_t; (void)Wcq_t; (void)Wckv_t; (void)Wco_t; (void)Wup_t; (void)Wdn_t; (void)memn; (void)memkv; (void)XB; (void)QC; (void)Z; (void)HB;
__global__ void __launch_bounds__(NWAVES * 64, 2) mega_fwd(Args args) {
    extern __shared__ __attribute__((aligned(16))) unsigned char lds[];
    LAS unsigned char* L = (LAS unsigned char*)lds;
    cg::grid_group grid = cg::this_grid();
    const int tid = threadIdx.x, lane = tid & 63, wave = __builtin_amdgcn_readfirstlane(tid >> 6);
    const int G = gridDim.x, bx = blockIdx.x;
    const int vcu = (G % 8 == 0) ? (bx % 8) * (G / 8) + bx / 8 : bx;
    const int gw = vcu * NWAVES + wave, NGW = G * NWAVES;
    const int lo = args.ph_lo, hi = args.ph_hi; int ph = 0;
    volatile LAS unsigned* bst = (volatile LAS unsigned*)(L + LDS_MISC_OFF);
    if (threadIdx.x < 4) bst[threadIdx.x] = 0u;
    __syncthreads();
    XcdBarrier xbar; xbar.bar = (unsigned*)(args.ws + WS_BAR); xbar.x = 0; xbar.st = bst;
    if (hi - lo > 1) xbar = xcd_barrier_post((unsigned*)(args.ws + WS_BAR), bst);
#ifndef PH_MASK
#define PH_MASK 0xffff
#endif
#ifndef DUP_P0
#define DUP_P0 0
#endif
#ifndef DUP_A
#define DUP_A 0
#endif
#ifndef DUP_GQA
#define DUP_GQA 0
#endif
#ifndef DUP_NA
#define DUP_NA 0
#endif
#ifndef DUP_I
#define DUP_I 0
#endif
#ifndef DUP_SYNC
#define DUP_SYNC 0
#endif
#ifndef DUP_G
#define DUP_G 0
#endif
#ifndef DUP_F
#define DUP_F 0
#endif
#define PHON(b) ((PH_MASK >> (b)) & 1)
#define RUN() (ph >= lo && ph < hi)
#define SEAM() do { if (ph >= lo && ph + 1 < hi) { if (lo < 0) grid.sync(); else xcd_barrier(xbar); for (int r_ = 0; r_ < DUP_SYNC; ++r_) xcd_barrier(xbar); } ++ph; } while (0)

    if (PHON(0) && RUN()) { PP
      _Pragma("unroll 1") for (int rep = 0; rep <= DUP_P0; ++rep) {
        for (int i = gw * 64 + lane; i < 3 * NTOK; i += NGW * 64) ss1[i] = 0.f;
        LAS float* scr = (LAS float*)(L + wave * 16384);
        constexpr int I_IN = (DM / 64) * (DIN / 32), I_PA = (1024 / 64) * (DM / 32), I_O = (DM / 64) * (DM / 32), I_CQ = (DM / 64) * (CWID / 32), I_CKV = (DM / 64) * (1024 / 32),
                      I_CO = (CWID / 64) * (DM / 32), I_UP = (DM / 64) * (DFF / 32), I_DN = (DFF / 64) * (DM / 32);
        constexpr int NITEMS = I_IN + 2 * I_PA + I_O + I_CQ + I_CKV + I_CO + I_UP + I_DN;
        const float W8M = (float)(1 << W8_SHIFT);
#define TI_VARS(P) const float* P##src = nullptr; int P##ldw = 0, P##K = 0, P##k0 = 0, P##n0 = 0, P##kind = 0; const float* P##gain = nullptr; float P##mul = 1.f; unsigned char* P##dst = nullptr; f32x4 P##w[8]
#define TI_REFS(P) P##src, P##ldw, P##K, P##k0, P##n0, P##kind, P##gain, P##mul, P##dst
#define TI_DECODE(P, it_) do { int r = (it_); \
            if (r < I_IN) { ti_set(TI_REFS(P), ap->in[5], DM, DIN, Win8, ap->in[4], W8M, 1, r); break; } r -= I_IN; \
            if (r < I_PA) { ti_set(TI_REFS(P), ap->in[9], 1024, DM, Wpa_t, nullptr, W8M, 1, r); break; } r -= I_PA; \
            if (r < I_PA) { ti_set(TI_REFS(P), ap->in[10], 1024, DM, Wpb_t, nullptr, W8M, 1, r); break; } r -= I_PA; \
            if (r < I_O) { ti_set(TI_REFS(P), ap->in[11], DM, DM, Wo_t, nullptr, W8M, 1, r); break; } r -= I_O; \
            if (r < I_CQ) { ti_set(TI_REFS(P), ap->in[14], DM, CWID, Wcq_t, ap->in[12], 1.0f, 0, r); break; } r -= I_CQ; \
            if (r < I_CKV) { ti_set(TI_REFS(P), ap->in[15], DM, 1024, Wckv_t, ap->in[13], 1.0f, 0, r); break; } r -= I_CKV; \
            if (r < I_CO) { ti_set(TI_REFS(P), ap->in[16], CWID, DM, Wco_t, nullptr, 1.0f, 0, r); break; } r -= I_CO; \
            if (r < I_UP) { ti_set(TI_REFS(P), ap->in[18], DM, DFF, Wup_t, ap->in[17], 1.0f, 0, r); break; } r -= I_UP; \
            ti_set(TI_REFS(P), ap->in[19], DFF, DM, Wdn_t, nullptr, 1.0f, 0, r); } while (0)
#define TI_LOAD(P) ti_load(P##w, P##src, P##ldw, P##k0, P##n0, lane)
#define TI_PROC(P) ti_process(P##w, P##K, P##k0, P##n0, P##kind, P##gain, P##mul, P##dst, scr, lane)
        { TI_VARS(ta_); TI_VARS(tb_); int it = gw;
          if (it < NITEMS) { TI_DECODE(ta_, it); TI_LOAD(ta_); }
          while (it < NITEMS) {
              const int it2 = it + NGW; const bool hb = it2 < NITEMS; if (hb) { TI_DECODE(tb_, it2); TI_LOAD(tb_); }
              TI_PROC(ta_); if (!hb) break;
              const int it3 = it2 + NGW; const bool ha = it3 < NITEMS; if (ha) { TI_DECODE(ta_, it3); TI_LOAD(ta_); }
              TI_PROC(tb_); if (!ha) break;
              it = it3; } }
#undef TI_DECODE
#undef TI_VARS
#undef TI_REFS
#undef TI_LOAD
#undef TI_PROC
        for (int m = gw; m < NTOK; m += 2 * NGW) {
            const int m2 = m + NGW; const float* xa = (m < 32768) ? ap->in[0] + (size_t)m * DM : ap->in[1] + (size_t)(m - 32768) * DM;
            if (m2 < NTOK) { const float* xb2 = (m2 < 32768) ? ap->in[0] + (size_t)m2 * DM : ap->in[1] + (size_t)(m2 - 32768) * DM; rms_row2_to_fp8(xa, xb2, XN8 + (size_t)m * DM, XN8 + (size_t)m2 * DM, lane); }
            else rms_row_to_fp8(xa, XN8 + (size_t)m * DM, lane); }
        for (int m = gw; m < NMEMROWS; m += NGW) { const float* xr = (m < 1024) ? ap->in[2] + (size_t)m * DM : ap->in[3] + (size_t)(m - 1024) * DM; rms_row_to_bf16(xr, memn + (size_t)m * DM, lane); }
      }
    }
    SEAM();

#pragma unroll 1
    for (int c = 0; c < NCH; ++c) {
        const int row0 = c * 32768, CR = (c == 0) ? 32768 : 16384, nb = (c == 0) ? 4 : 1, seq = (c == 0) ? 8192 : 16384;
        if (PHON(1) && RUN()) { PP
            pg8::Gemm g{(const bf16_t*)(XN8 + (size_t)row0 * DM), (const bf16_t*)Win8, CR, DIN, DM / 2, DM / 2, 0}; pg8::StaticOrder S; S.init(CR, DIN, G, bx);
            pg8::EpiB E{Z, 0, 1, nullptr, 0};
            _Pragma("unroll 1") for (int rep = 0; rep <= DUP_A; ++rep)
            pg8::gemm_phase<pg8::EpiB, pg8::StaticOrder, true>(L, g, S, E);
        }
        SEAM();
        if (PHON(2) && RUN()) { PP
            rope_pass(Z + Z_GQ, Q8, 1024, CR, seq, ap->in[7], att::QPRE, gw, NGW, lane);
            rope_pass(Z + Z_GK, K8, 256, CR, seq, ap->in[8], 1.0f, gw, NGW, lane);
            vt_pass(Z + Z_GV, VT8, CR, seq, gw, NGW, lane);
        }
        SEAM();
        if (PHON(3) && RUN()) { PP
            const int nqb = seq / 256, NU = nb * 8 * nqb, nper = (NU + G - 1) / G;
            att::NaCtx na0{0, 0, 0, 0, 0, nullptr};
            bf16_t* DUMMY = (bf16_t*)(ws + 981 * MiB); (void)DUMMY;
            _Pragma("unroll 1") for (int rep = 0; rep <= DUP_GQA; ++rep)
            for (int i = 0; i < nper; ++i) { const int u = vcu * nper + i; if (u >= NU) break;
                const int qb = u % nqb; int t = u / nqb; const int gq = t % 4; t /= 4; const int kvh = t % 2, b = t / 2, h = kvh * 4 + gq;
                const size_t qoff = ((size_t)b * seq + (size_t)qb * 256) * 1024 + h * 128;
                att::attn_body_f8<1024, 256, 1024, OB_SHIFT>(Q8 + qoff, K8 + (size_t)b * seq * 256 + kvh * 128, VT8 + ((size_t)(b * 2 + kvh) * 128) * (size_t)seq, (long)seq, O8B + qoff, seq, (char*)lds);
            }
            __syncthreads();
            const int rows = seq / 64;
            _Pragma("unroll 1") for (int rep = 0; rep <= DUP_NA; ++rep)
            for (int i = 0; i < nper; ++i) { const int u = vcu * nper + i; if (u >= NU) break;
                const int h = u % 8; int t = u / 8; const int rg = t % nqb, b = t / nqb, R0 = 4 * rg;
                int kr0 = R0 - 4; kr0 = kr0 < 0 ? 0 : (kr0 > rows - 12 ? rows - 12 : kr0);
                LAS float* tb = (LAS float*)(L + att::NA_TBL_OFF) + att::NA_TBL_PAD;
                if (tid < 15 * 32) { const int dr = tid >> 5, dc = tid & 31; tb[tid] = (dc < 31) ? ap->in[6][(h * 15 + dr) * 31 + dc] * (1.0f / att::SCALE) : 0.f; }
                att::NaCtx na; na.r = R0 + (wave >> 1); na.rs = na.r - 4 < 0 ? 0 : (na.r - 4 > rows - 8 ? rows - 8 : na.r - 4);
                na.c = (wave & 1) * 32 + (lane & 31); na.cs = na.c - 8 < 0 ? 0 : (na.c - 8 > 48 ? 48 : na.c - 8); na.kr0 = kr0; na.tbl = tb;
                bf16_t* Q = Z + Z_NAQ + ((size_t)b * seq + (size_t)R0 * 64) * 1024 + h * 128;
                const bf16_t* Kp = Z + Z_NAK + ((size_t)b * seq + (size_t)kr0 * 64) * 1024 + h * 128; const bf16_t* Vp = Z + Z_NAV + ((size_t)b * seq + (size_t)kr0 * 64) * 1024 + h * 128;
                att::attn_body<1024, 1024, 1024, true, OA_SHIFT>(Q, Kp, Vp, (bf16_t*)(O8A + ((size_t)b * seq + (size_t)R0 * 64) * 1024 + h * 128), 12 * 64, (char*)lds, na);
            }
            __syncthreads();
        }
        SEAM();
        if (PHON(4) && RUN()) { PP
            { pg8::Gemm g{(const bf16_t*)O8A, Wpa_t, CR, DM, 512, 512, OA_SHIFT}; pg8::StaticOrder S; S.init(CR, DM, G, bx);
              pg8::EpiGate E{Z + Z_GA, Z + Z_GA, nullptr, 0}; pg8::gemm_phase<pg8::EpiGate, pg8::StaticOrder, true>(L, g, S, E); }
            { pg8::Gemm g{(const bf16_t*)O8B, Wpb_t, CR, DM, 512, 512, OB_SHIFT}; pg8::StaticOrder S; S.init(CR, DM, G, bx);
              pg8::EpiGate E{Z + Z_GB, Z + Z_GA, M8, 1}; pg8::gemm_phase<pg8::EpiGate, pg8::StaticOrder, true>(L, g, S, E); }
        }
        SEAM();
        if (PHON(5) && RUN()) { PP
            const float* xin = (c == 0) ? ap->in[0] : ap->in[1];
            pg8::Gemm g{(const bf16_t*)M8, Wo_t, CR, DM, DM / 2, DM / 2, MX_SHIFT}; pg8::StaticOrder S; S.init(CR, DM, G, bx);
            pg8::EpiRes<true> E{xin, nullptr, XB + (size_t)row0 * DM, ss1 + row0};
            pg8::gemm_phase<pg8::EpiRes<true>, pg8::StaticOrder, true>(L, g, S, E);
        }
        SEAM();
    }
    if (PHON(6) && RUN()) { PP
        { pg8::Gemm g{XB, Wcq_t, NTOK, CWID, DM, DM, 0}; pg8::StaticOrder S; S.init(NTOK, CWID, G, bx);
          pg8::EpiB E{QC, CWID, 0, ss1, 0};
          _Pragma("unroll 1") for (int rep = 0; rep <= DUP_F; ++rep)
          pg8::gemm_phase<pg8::EpiB, pg8::StaticOrder>(L, g, S, E); }
        { pg8::Gemm g{memn, Wckv_t, NMEMROWS, 1024, DM, DM, 0}; pg8::StaticOrder S; S.init(NMEMROWS, 1024, G, (bx + G / 2) % G);
          pg8::EpiB E{memkv, 1024, 0, nullptr, 0}; pg8::gemm_phase<pg8::EpiB, pg8::StaticOrder>(L, g, S, E); }
    }
    SEAM();
    if (PHON(7) && RUN()) { PP
        const int NU = (NTOK / 256) * 4, nper = (NU + G - 1) / G;
        att::NaCtx na0{0, 0, 0, 0, 0, nullptr};
        bf16_t* DUMMY = (bf16_t*)(ws + 981 * MiB); (void)DUMMY;
        _Pragma("unroll 1") for (int rep = 0; rep <= DUP_G; ++rep)
        for (int i = 0; i < nper; ++i) { const int u = vcu * nper + i; if (u >= NU) break;
            const int h = u % 4, rb = u / 4, b = (rb < 128) ? (rb >> 5) : 4;
            bf16_t* Q = QC + (size_t)rb * 256 * CWID + h * 128;
            const bf16_t* Kp = memkv + (size_t)b * 256 * 1024 + h * 128; const bf16_t* Vp = Kp + 512;
            att::attn_body<512, 1024, 512, false>(Q, Kp, Vp, (rep < DUP_G) ? DUMMY + (Q - QC) : Q, 256, (char*)lds, na0);
        }
        __syncthreads();
    }
    SEAM();
    if (PHON(8) && RUN()) { PP
        pg8::Gemm g{QC, Wco_t, NTOK, DM, CWID, CWID, 0}; pg8::StaticOrder S; S.init(NTOK, DM, G, bx);
        pg8::EpiRes<false> E{nullptr, XB, XB, ss2}; pg8::gemm_phase<pg8::EpiRes<false>, pg8::StaticOrder>(L, g, S, E);
    }
    SEAM();
#pragma unroll 1
    for (int c = 0; c < NCH; ++c) {
        const int row0 = c * 32768, CR = (c == 0) ? 32768 : 16384;
        if (PHON(9) && RUN()) { PP
            pg8::Gemm g{XB + (size_t)row0 * DM, Wup_t, CR, DFF, DM, DM, 0}; pg8::StaticOrder S; S.init(CR, DFF, G, bx);
            pg8::EpiB E{HB, DFF, 0, ss2 + row0, 1};
            _Pragma("unroll 1") for (int rep = 0; rep <= DUP_I; ++rep)
            pg8::gemm_phase<pg8::EpiB, pg8::StaticOrder>(L, g, S, E);
        }
        SEAM();
        if (PHON(10) && RUN()) { PP
            pg8::Gemm g{HB, Wdn_t, CR, DM, DFF, DFF, 0}; pg8::StaticOrder S; S.init(CR, DM, G, bx);
            pg8::EpiRes<false> E{nullptr, XB + (size_t)row0 * DM, XB + (size_t)row0 * DM, ss3 + row0}; pg8::gemm_phase<pg8::EpiRes<false>, pg8::StaticOrder>(L, g, S, E);
        }
        SEAM();
    }
    if (PHON(11) && RUN()) { PP
        const float* gf = ap->in[20];
        f32x4 gv[8];
#pragma unroll
        for (int j = 0; j < 8; ++j) gv[j] = *((const f32x4*)gf + lane + 64 * j);
        for (int m = gw; m < NTOK; m += NGW) { const float rr = __builtin_amdgcn_rsqf(ss3[m] * (1.f / DM) + EPS);
            const u32x2* xb = (const u32x2*)(XB + (size_t)m * DM) + lane; f32x4* xr = (f32x4*)(out + (size_t)m * DM) + lane;
            u32x2 r[8];
#pragma unroll
            for (int j = 0; j < 8; ++j) r[j] = xb[64 * j];
#pragma unroll
            for (int j = 0; j < 8; ++j) { f32x4 v = (f32x4){bf_lo(r[j].x), bf_hi(r[j].x), bf_lo(r[j].y), bf_hi(r[j].y)}; v = v * rr * gv[j]; xr[64 * j] = v; } }
    }
#undef RUN
#undef SEAM
}

extern "C" void kernel_launch(void* const* d_in, const int* in_sizes, int n_in, void* d_out, int out_size, void* d_ws, size_t ws_size, hipStream_t stream) {
    static int grid = 0;
    if (grid == 0) {
        if (n_in != 21 || out_size != NTOK * DM || ws_size < WS_END) { fprintf(stderr, "kernel_launch: unexpected shapes n_in %d out %d ws %zu\n", n_in, out_size, ws_size); grid = -1; return; }
        int dev = 0, cus = 0, per_cu = 0;
        if (hipGetDevice(&dev) != hipSuccess || hipDeviceGetAttribute(&cus, hipDeviceAttributeMultiprocessorCount, dev) != hipSuccess) { grid = -1; return; }
        if (hipFuncSetAttribute((const void*)mega_fwd, hipFuncAttributeMaxDynamicSharedMemorySize, LDS_BYTES) != hipSuccess) { fprintf(stderr, "kernel_launch: hipFuncSetAttribute failed\n"); grid = -1; return; }
        if (hipOccupancyMaxActiveBlocksPerMultiprocessor(&per_cu, (const void*)mega_fwd, NWAVES * 64, LDS_BYTES) != hipSuccess || per_cu < 1) per_cu = 1;
        (void)hipGetLastError();
        grid = cus * 1;
        (void)per_cu;
    }
    if (grid < 0) return;
    Args a{};
    for (int i = 0; i < 21; ++i) a.in[i] = (const float*)d_in[i];
    a.out = (float*)d_out; a.ws = (unsigned char*)d_ws;
#if MK_MULTI
    for (int p = 0; p < NPH; ++p) { a.ph_lo = p; a.ph_hi = p + 1; hipLaunchKernelGGL(mega_fwd, dim3(grid), dim3(NWAVES * 64), LDS_BYTES, stream, a); }
#else
    a.ph_lo = 0; a.ph_hi = NPH;
    if (hipMemsetAsync((char*)d_ws + WS_BAR, 0, XCD_BAR_WORDS * 4, stream) != hipSuccess) { fprintf(stderr, "kernel_launch: memset of barrier words failed\n"); return; }
    void* kargs[] = {&a};
    hipError_t e = hipLaunchCooperativeKernel((const void*)mega_fwd, dim3(grid), dim3(NWAVES * 64), kargs, LDS_BYTES, stream);
    if (e != hipSuccess) fprintf(stderr, "cooperative launch failed: %s (grid %d)\n", hipGetErrorString(e), grid);
#endif
}
```

```cpp
#include <hip/hip_runtime.h>
#include <hip/hip_bf16.h>
#include <hip/hip_cooperative_groups.h>
#include <cstdio>
#include <cstdint>
#include <cmath>
#include <type_traits>
namespace cg = cooperative_groups;

#ifndef MK_MULTI
#define MK_MULTI 0
#endif

#define LAS __attribute__((address_space(3)))
typedef unsigned short bf16_t;
typedef short bf16x8 __attribute__((ext_vector_type(8)));
typedef short s16x4 __attribute__((ext_vector_type(4)));
typedef float f32x2 __attribute__((ext_vector_type(2)));
typedef float f32x4 __attribute__((ext_vector_type(4)));
typedef float f32x16 __attribute__((ext_vector_type(16)));
typedef unsigned u32x2 __attribute__((ext_vector_type(2)));
typedef unsigned u32x4 __attribute__((ext_vector_type(4)));
typedef int i32x4 __attribute__((ext_vector_type(4)));
typedef int i32x8 __attribute__((ext_vector_type(8)));

constexpr int DM = 2048, NTOK = 49152, CH = 32768  , NCH = 2, DIN = 8704, DFF = 8192, NMEMROWS = 1280, CWID = 512;
constexpr float EPS = 1e-6f;
constexpr size_t MiB = 1u << 20;
constexpr size_t WS_SS = 0;
constexpr size_t WS_WIN = 1 * MiB, WS_WPA = 35 * MiB, WS_WPB = 39 * MiB, WS_WO = 43 * MiB, WS_WCQ = 51 * MiB, WS_WCKV = 53 * MiB,
                 WS_WCO = 57 * MiB, WS_WUP = 59 * MiB, WS_WDN = 91 * MiB, WS_MEMN = 123 * MiB, WS_MEMKV = 128 * MiB, WS_XB = 131 * MiB,
                 WS_QC = 323 * MiB, WS_Z = 371 * MiB, WS_ZEND = 915 * MiB, WS_XN8 = WS_XB + 96 * MiB  , WS_O8A = 916 * MiB, WS_O8B = 948 * MiB  , WS_END = 980 * MiB;
constexpr size_t Z_NAQ = 0, Z_NAK = (size_t)CH * 1024, Z_NAV = (size_t)2 * CH * 1024, Z_GQ = (size_t)3 * CH * 1024, Z_GK = (size_t)4 * CH * 1024,
                 Z_GV = Z_GK + (size_t)CH * 256, Z_GA = Z_GV + (size_t)CH * 256, Z_GB = Z_GA + (size_t)CH * 2048;
static_assert((Z_GB + (size_t)CH * 2048) * 2 <= WS_ZEND - WS_Z, "z region");
static_assert((size_t)CH * DFF * 2 <= WS_ZEND - WS_Z, "h overlay");
constexpr int W8_SHIFT = 5, OA_SHIFT = 4, OB_SHIFT = 5, MX_SHIFT = 4;

__device__ __forceinline__ unsigned cvt_pk_bf16(float lo, float hi) { unsigned r; asm volatile("v_cvt_pk_bf16_f32 %0, %1, %2" : "=v"(r) : "v"(lo), "v"(hi)); return r; }
__device__ __forceinline__ unsigned pack4_fp8(float a, float b, float c, float d) { int r = 0; r = __builtin_amdgcn_cvt_pk_fp8_f32(a, b, r, false); r = __builtin_amdgcn_cvt_pk_fp8_f32(c, d, r, true); return (unsigned)r; }
__device__ __forceinline__ float bf_lo(unsigned w) { return __uint_as_float(w << 16); }
__device__ __forceinline__ float bf_hi(unsigned w) { return __uint_as_float(w & 0xffff0000u); }
__device__ __forceinline__ float sigmoidf_(float x) { return __builtin_amdgcn_rcpf(1.0f + __builtin_amdgcn_exp2f(-1.4426950408889634f * x)); }

namespace pg8 {
constexpr int BM = 256, BK = 64, HALF = 128, HTB = HALF * BK * 2, STAGE_BYTES = 8 * HTB, NXCD = 8, WGM = 8;
__host__ __device__ __forceinline__ int lds_byte(int r, int c) { const int st = (r >> 4) * 2 + (c >> 5), rr = r & 15, cc = c & 31, ob = rr * 64 + cc * 2; return st * 1024 + (ob ^ (((ob >> 9) & 1) << 5)); }
__host__ __device__ __forceinline__ void stage_rc(int b, int& R, int& C) { const int st = b / 1024, sb = b % 1024, swz = sb ^ (((sb >> 9) & 1) << 5); R = (st >> 1) * 16 + swz / 64; C = (st & 1) * 32 + (swz % 64) / 2; }
__host__ __device__ __forceinline__ int perm32(int rho) { const int n = rho >> 4, i = rho & 15; return 8 * (i >> 2) + 4 * n + (i & 3); }
struct Unit { int pm, pn; };
struct Gemm { const bf16_t* A; const bf16_t* Bt; int M, N, K, lda; int xshift; };
struct StaticOrder {
    int nM, nN, nwg, G, c, wgm;
    __device__ void init(int M, int N, int G_, int c_, int wgm_ = WGM) { nM = M / BM; nN = N / BM; nwg = nM * nN; G = G_; c = c_; wgm = wgm_; }
    __device__ bool next(int i, Unit& u) const {
        const long L = (long)i * G + c; if (L >= nwg) return false;
        int wgid = (int)L; { const int q = nwg / NXCD, r = nwg % NXCD, xcd = wgid % NXCD, off = wgid / NXCD; wgid = (xcd < r ? xcd * (q + 1) : r * (q + 1) + (xcd - r) * q) + off; }
        const int nig = wgm * nN, gid = wgid / nig, fm = gid * wgm, gsz = (nM - fm) < wgm ? (nM - fm) : wgm;
        u.pm = fm + ((wgid % nig) % gsz); u.pn = (wgid % nig) / gsz; return true;
    }
};

struct EpiB {
    static constexpr bool PERM = true;
    bf16_t* O; int ldc; int route; const float* ss; int act;
    __device__ __forceinline__ void operator()(const f32x4 (&acc)[2][2][4][2], const Unit& u, int wr, int wc, int fr, int fq) const {
        const int row0 = u.pm * BM + wr * 64 + fr; bf16_t* base = O; int ld = ldc, colt = u.pn * BM;
        if (route) { const int pn = u.pn;
            if (pn < 16) { base += (size_t)(pn >> 2) * ((size_t)CH * 1024); ld = 1024; colt = (pn & 3) * 256; }
            else if (pn < 18) { base += Z_GK + (size_t)(pn - 16) * ((size_t)CH * 256); ld = 256; colt = 0; }
            else { base += Z_GA + (size_t)((pn - 18) >> 3) * ((size_t)CH * 2048); ld = 2048; colt = ((pn - 18) & 7) * 256; } }
        const int col0 = colt + wc * 32 + 8 * fq;
#pragma unroll
        for (int ai = 0; ai < 2; ++ai)
#pragma unroll
            for (int m = 0; m < 4; ++m) { const int row = row0 + ai * HALF + m * 16; float sc = 1.f;
                if (ss) sc = __builtin_amdgcn_rsqf(ss[row] * (1.0f / DM) + EPS);
                bf16_t* rowp = base + (size_t)row * ld + col0;
#pragma unroll
                for (int bj = 0; bj < 2; ++bj) { f32x4 v0 = acc[ai][bj][m][0] * sc, v1 = acc[ai][bj][m][1] * sc;
                    if (act) {
#pragma unroll
                        for (int e = 0; e < 4; ++e) { float a = fmaxf(v0[e], 0.f), b = fmaxf(v1[e], 0.f); v0[e] = a * a; v1[e] = b * b; } }
                    u32x4 w; w.x = cvt_pk_bf16(v0[0], v0[1]); w.y = cvt_pk_bf16(v0[2], v0[3]); w.z = cvt_pk_bf16(v1[0], v1[1]); w.w = cvt_pk_bf16(v1[2], v1[3]);
                    *(u32x4*)(rowp + bj * HALF) = w; } }
    }
};
struct EpiGate {
    static constexpr bool PERM = true;
    const bf16_t* G; bf16_t* T; unsigned char* M8; int second;
    __device__ __forceinline__ void ldgrp(u32x4 (&gg)[2], u32x4 (&tt)[2], size_t ro) const {
#pragma unroll
        for (int bj = 0; bj < 2; ++bj) { gg[bj] = *(const u32x4*)(G + ro + bj * HALF); if (second) tt[bj] = *(const u32x4*)(T + ro + bj * HALF); else tt[bj] = (u32x4){0u, 0u, 0u, 0u}; }
    }
    __device__ __forceinline__ void operator()(const f32x4 (&acc)[2][2][4][2], const Unit& u, int wr, int wc, int fr, int fq) const {
        const int row0 = u.pm * BM + wr * 64 + fr, col0 = u.pn * BM + wc * 32 + 8 * fq;
        u32x4 gg[2], tt[2], gn[2], tn[2];
        ldgrp(gg, tt, (size_t)row0 * 2048 + col0);
#pragma unroll
        for (int gi = 0; gi < 8; ++gi) { const int ai = gi >> 2, m = gi & 3; const size_t ro = (size_t)(row0 + ai * HALF + m * 16) * 2048 + col0;
            if (gi < 7) ldgrp(gn, tn, (size_t)(row0 + ((gi + 1) >> 2) * HALF + ((gi + 1) & 3) * 16) * 2048 + col0);
#pragma unroll
            for (int bj = 0; bj < 2; ++bj) { const u32x4 g = gg[bj];
                f32x4 v0 = acc[ai][bj][m][0], v1 = acc[ai][bj][m][1];
                v0[0] *= sigmoidf_(bf_lo(g.x)); v0[1] *= sigmoidf_(bf_hi(g.x)); v0[2] *= sigmoidf_(bf_lo(g.y)); v0[3] *= sigmoidf_(bf_hi(g.y));
                v1[0] *= sigmoidf_(bf_lo(g.z)); v1[1] *= sigmoidf_(bf_hi(g.z)); v1[2] *= sigmoidf_(bf_lo(g.w)); v1[3] *= sigmoidf_(bf_hi(g.w));
                if (second) { const u32x4 t = tt[bj];
                    v0[0] += bf_lo(t.x); v0[1] += bf_hi(t.x); v0[2] += bf_lo(t.y); v0[3] += bf_hi(t.y);
                    v1[0] += bf_lo(t.z); v1[1] += bf_hi(t.z); v1[2] += bf_lo(t.w); v1[3] += bf_hi(t.w);
                    constexpr float MS = (float)(1 << MX_SHIFT); v0 = v0 * MS; v1 = v1 * MS;
                    u32x2 w; w.x = pack4_fp8(v0[0], v0[1], v0[2], v0[3]); w.y = pack4_fp8(v1[0], v1[1], v1[2], v1[3]);
                    *(u32x2*)(M8 + ro + bj * HALF) = w; }
                else { u32x4 w; w.x = cvt_pk_bf16(v0[0], v0[1]); w.y = cvt_pk_bf16(v0[2], v0[3]); w.z = cvt_pk_bf16(v1[0], v1[1]); w.w = cvt_pk_bf16(v1[2], v1[3]);
                    *(u32x4*)(T + ro + bj * HALF) = w; } }
#pragma unroll
            for (int bj = 0; bj < 2; ++bj) { gg[bj] = gn[bj]; tt[bj] = tn[bj]; }
        }
    }
};
template <bool XF>
struct EpiRes {
    static constexpr bool PERM = false;
    const float* Xf; const bf16_t* Xb; bf16_t* XB; float* ss;
    typedef typename std::conditional<XF, f32x4, u32x2>::type raw_t;
    __device__ __forceinline__ void ldgrp(raw_t (&r)[2][2], size_t ro) const {
#pragma unroll
        for (int bj = 0; bj < 2; ++bj)
#pragma unroll
            for (int n = 0; n < 2; ++n) { const size_t off = ro + bj * HALF + n * 16;
                if constexpr (XF) r[bj][n] = *(const f32x4*)(Xf + off); else r[bj][n] = *(const u32x2*)(Xb + off); }
    }
    __device__ __forceinline__ void operator()(const f32x4 (&acc)[2][2][4][2], const Unit& u, int wr, int wc, int fr, int fq) const {
        const int row0 = u.pm * BM + wr * 64 + fr, col0 = u.pn * BM + wc * 32 + 4 * fq;
        raw_t cur[2][2], nxt[2][2];
        ldgrp(cur, (size_t)row0 * 2048 + col0);
#pragma unroll
        for (int g = 0; g < 8; ++g) { const int ai = g >> 2, m = g & 3;
            if (g < 7) ldgrp(nxt, (size_t)(row0 + ((g + 1) >> 2) * HALF + ((g + 1) & 3) * 16) * 2048 + col0);
            const int row = row0 + ai * HALF + m * 16; const size_t ro = (size_t)row * 2048 + col0; float s = 0.f;
#pragma unroll
            for (int bj = 0; bj < 2; ++bj)
#pragma unroll
                for (int n = 0; n < 2; ++n) { const size_t off = ro + bj * HALF + n * 16;
                    f32x4 x;
                    if constexpr (XF) x = cur[bj][n]; else x = (f32x4){bf_lo(cur[bj][n].x), bf_hi(cur[bj][n].x), bf_lo(cur[bj][n].y), bf_hi(cur[bj][n].y)};
                    const f32x4 v = x + acc[ai][bj][m][n];
                    s += (v[0] * v[0] + v[1] * v[1]) + (v[2] * v[2] + v[3] * v[3]);
                    u32x2 w; w.x = cvt_pk_bf16(v[0], v[1]); w.y = cvt_pk_bf16(v[2], v[3]); *(u32x2*)(XB + off) = w; }
            s += __shfl_xor(s, 16); s += __shfl_xor(s, 32);
            if (fq == 0) unsafeAtomicAdd(ss + row, s);
#pragma unroll
            for (int bj = 0; bj < 2; ++bj)
#pragma unroll
                for (int n = 0; n < 2; ++n) cur[bj][n] = nxt[bj][n];
        }
    }
};

template <class Epi, class Sched, bool FP8 = false>
__device__ __forceinline__ void gemm_phase(LAS unsigned char* lds, const Gemm g, const Sched& S, const Epi& E) {
    int tid_ = threadIdx.x; asm volatile("" : "+v"(tid_));
    const int tid = tid_, wid = __builtin_amdgcn_readfirstlane(tid >> 6), lane = tid & 63, wr = wid >> 2, wc = wid & 3, fr = lane & 15, fq = lane >> 4;
    const int K = g.K, nt = K / BK, lda = g.lda;
    unsigned voffA[2], voffB[2];
#pragma unroll
    for (int i = 0; i < 2; ++i) { int R, C; stage_rc(tid * 16 + i * 8192, R, C); const int Rb = Epi::PERM ? ((R & ~31) + perm32(R & 31)) : R;
        voffA[i] = (unsigned)(R * lda + C) * 2u; voffB[i] = (unsigned)(Rb * K + C) * 2u; }
    const size_t kstep = (size_t)(BK * 2);
    const size_t hstepA = (size_t)HALF * lda * 2, hstepB = (size_t)HALF * K * 2, tstepA = 2 * hstepA, tstepB = 2 * hstepB;
    const unsigned ldsw = (unsigned)wid * 1024u;
    const int aoff = lds_byte(wr * 64 + fr, fq * 8), boff = lds_byte(wc * 32 + fr, fq * 8);
#define PG8_SA(b, h) (((b) * 2 + (h)) * HTB)
#define PG8_SB(b, h) ((4 + (b) * 2 + (h)) * HTB)
#define PG8_STAGE(bufoff, gbase, voff) do { _Pragma("unroll") for (int _i = 0; _i < 2; ++_i) \
        __builtin_amdgcn_global_load_lds((const unsigned*)((const char*)(gbase) + (voff)[_i]), (LAS unsigned*)(lds + (bufoff) + ldsw + _i * 8192), 16, 0, 0); } while (0)
#define PG8_LD2(p) __builtin_shufflevector(*(const LAS i32x4*)(p), *(const LAS i32x4*)((p) + 1024), 0, 1, 2, 3, 4, 5, 6, 7)
#define PG8_LDA(dst, b, h) do { _Pragma("unroll") for (int m = 0; m < 4; ++m) dst[m] = PG8_LD2(lds + PG8_SA(b, h) + aoff + m * 2048); } while (0)
#define PG8_LDB(dst, b, h) do { _Pragma("unroll") for (int n = 0; n < 2; ++n) dst[n] = PG8_LD2(lds + PG8_SB(b, h) + boff + n * 2048); } while (0)
#define PG8_LO(x) __builtin_bit_cast(bf16x8, __builtin_shufflevector(x, x, 0, 1, 2, 3))
#define PG8_HI(x) __builtin_bit_cast(bf16x8, __builtin_shufflevector(x, x, 4, 5, 6, 7))
#define PG8_MMA(ai, bj, At, Bt) do { __builtin_amdgcn_s_setprio(1); _Pragma("unroll") for (int m = 0; m < 4; ++m) _Pragma("unroll") for (int n = 0; n < 2; ++n) { \
        if constexpr (FP8) asm volatile("v_mfma_scale_f32_16x16x128_f8f6f4 %0, %1, %2, %0, %3, %4 op_sel_hi:[0,0,0]" : "+v"(acc[ai][bj][m][n]) : "v"(Bt[n]), "v"(At[m]), "v"(scl_w), "v"(scl_x)); \
        else { acc[ai][bj][m][n] = __builtin_amdgcn_mfma_f32_16x16x32_bf16(PG8_LO(Bt[n]), PG8_LO(At[m]), acc[ai][bj][m][n], 0, 0, 0); \
               acc[ai][bj][m][n] = __builtin_amdgcn_mfma_f32_16x16x32_bf16(PG8_HI(Bt[n]), PG8_HI(At[m]), acc[ai][bj][m][n], 0, 0, 0); } } \
        __builtin_amdgcn_s_setprio(0); } while (0)
#define PG8_WAIT_V(n) asm volatile("s_waitcnt vmcnt(" #n ")" ::: "memory")
#define PG8_WAIT_L(n) asm volatile("s_waitcnt lgkmcnt(" #n ")" ::: "memory")
#define PG8_BAR __builtin_amdgcn_s_barrier()
#define PG8_SCHED __builtin_amdgcn_sched_barrier(0)
    Unit cur, nxt; int ui = 0;
    if (!S.next(0, cur)) return;
    f32x4 acc[2][2][4][2];
#pragma unroll
    for (int a = 0; a < 2; ++a)
#pragma unroll
        for (int b = 0; b < 2; ++b)
#pragma unroll
            for (int m = 0; m < 4; ++m)
#pragma unroll
                for (int n = 0; n < 2; ++n) acc[a][b][m][n] = (f32x4){0.f, 0.f, 0.f, 0.f};
    i32x8 At[4], B0[2], B1[2];
    int scl_w = 0x7f7f7f7f - W8_SHIFT * 0x01010101, scl_x = 0x7f7f7f7f - g.xshift * 0x01010101; asm volatile("" : "+v"(scl_w), "+v"(scl_x)); (void)scl_w; (void)scl_x;
    const char* cA = (const char*)g.A + (size_t)cur.pm * tstepA; const char* cB = (const char*)g.Bt + (size_t)cur.pn * tstepB;
    PG8_STAGE(PG8_SB(0, 0), cB, voffB); PG8_STAGE(PG8_SB(0, 1), cB + hstepB, voffB); PG8_STAGE(PG8_SA(0, 0), cA, voffA); PG8_STAGE(PG8_SA(0, 1), cA + hstepA, voffA);
    if (wr == 1) PG8_BAR;
    PG8_WAIT_V(2); PG8_BAR;
    PG8_STAGE(PG8_SB(1, 0), cB + kstep, voffB); PG8_STAGE(PG8_SA(1, 0), cA + kstep, voffA); PG8_STAGE(PG8_SB(1, 1), cB + hstepB + kstep, voffB);
    PG8_WAIT_V(6); PG8_BAR;
    for (;;) {
        const bool has_next = S.next(ui + 1, nxt);
        const char* nA = has_next ? (const char*)g.A + (size_t)nxt.pm * tstepA : cA; const char* nB = has_next ? (const char*)g.Bt + (size_t)nxt.pn * tstepB : cB;
        for (int t = 0; t < nt; t += 2) {
            const bool last = (t == nt - 2);
            const char* a1 = cA + (size_t)(t + 1) * kstep;
            const char* a2 = last ? nA : cA + (size_t)(t + 2) * kstep; const char* b2 = last ? nB : cB + (size_t)(t + 2) * kstep;
            const char* a3 = a2 + kstep; const char* b3 = b2 + kstep;
            PG8_LDB(B0, 0, 0); PG8_LDB(B1, 0, 1); PG8_SCHED; PG8_LDA(At, 0, 0); PG8_STAGE(PG8_SA(1, 1), a1 + hstepA, voffA);
            PG8_WAIT_V(8); PG8_WAIT_L(0); PG8_BAR; PG8_MMA(0, 0, At, B0); PG8_MMA(0, 1, At, B1); PG8_BAR; PG8_SCHED;
            PG8_LDA(At, 0, 1); PG8_STAGE(PG8_SB(0, 0), b2, voffB); PG8_STAGE(PG8_SB(0, 1), b2 + hstepB, voffB); PG8_STAGE(PG8_SA(0, 0), a2, voffA);
            PG8_WAIT_V(8); PG8_WAIT_L(0); PG8_BAR; PG8_MMA(1, 0, At, B0); PG8_MMA(1, 1, At, B1); PG8_BAR; PG8_SCHED;
            PG8_LDB(B0, 1, 0); PG8_LDB(B1, 1, 1); PG8_SCHED; PG8_LDA(At, 1, 0); PG8_STAGE(PG8_SA(0, 1), a2 + hstepA, voffA);
            PG8_WAIT_V(8); PG8_WAIT_L(0); PG8_BAR; PG8_MMA(0, 0, At, B0); PG8_MMA(0, 1, At, B1); PG8_BAR; PG8_SCHED;
            PG8_LDA(At, 1, 1); PG8_STAGE(PG8_SB(1, 0), b3, voffB); PG8_STAGE(PG8_SB(1, 1), b3 + hstepB, voffB); PG8_STAGE(PG8_SA(1, 0), a3, voffA);
            PG8_WAIT_V(8); PG8_WAIT_L(0); PG8_BAR; PG8_MMA(1, 0, At, B0); PG8_MMA(1, 1, At, B1); PG8_BAR; PG8_SCHED;
        }
        if (wr == 0) PG8_BAR;
        if constexpr (FP8) asm volatile("s_nop 15\n\ts_nop 15" ::: "memory");
        E(acc, cur, wr, wc, fr, fq);
        if (!has_next) break;
#pragma unroll
        for (int a = 0; a < 2; ++a)
#pragma unroll
            for (int b = 0; b < 2; ++b)
#pragma unroll
                for (int m = 0; m < 4; ++m)
#pragma unroll
                    for (int n = 0; n < 2; ++n) acc[a][b][m][n] = (f32x4){0.f, 0.f, 0.f, 0.f};
        cur = nxt; cA = nA; cB = nB; ++ui;
        if (wr == 1) PG8_BAR;
    }
    PG8_WAIT_V(0);
    PG8_BAR;
#undef PG8_SA
#undef PG8_SB
#undef PG8_STAGE
#undef PG8_LDA
#undef PG8_LDB
#undef PG8_MMA
#undef PG8_LD2
#undef PG8_LO
#undef PG8_HI
#undef PG8_WAIT_V
#undef PG8_WAIT_L
#undef PG8_BAR
#undef PG8_SCHED
}
}

namespace att {
constexpr int D = 128, NW = 8, QBLK = 32, KVBLK = 64;
constexpr float SCALE = 0.088388347648318440f;
constexpr int SHM_V = KVBLK * D * 2, SHM_K = KVBLK * D * 2, SHM_ATTN = 2 * SHM_V + 2 * SHM_K + NW * 64 * 4;
constexpr int NA_TBL_OFF = SHM_ATTN, NA_TBL_PAD = 48, NA_TBL_FLOATS = 48 + 15 * 32 + 96, ATT_LDS = NA_TBL_OFF + NA_TBL_FLOATS * 4;
#define KSWZ(row, colB) ((row) * 256 + ((colB) ^ (((row) & 7) << 4)))
#define SBAR() __builtin_amdgcn_sched_barrier(0)
__device__ __forceinline__ int crow(int r, int hi) { return (r & 3) + 8 * (r >> 2) + 4 * hi; }
__device__ __forceinline__ bf16x8 ld8(const bf16_t* p) { return *reinterpret_cast<const bf16x8*>(p); }

template <int THRV = 8>
__device__ __forceinline__ void partialSM(f32x16& p0, f32x16& p1, float& m_reg, float& mn, float& alpha) {
  constexpr float C = SCALE * 1.4426950408889634f; constexpr float THR = (float)THRV;
  float pmax = p0[0];
#pragma unroll
  for (int r = 1; r < 16; ++r) pmax = fmaxf(pmax, p0[r]);
#pragma unroll
  for (int r = 0; r < 16; ++r) pmax = fmaxf(pmax, p1[r]);
  { auto rr = __builtin_amdgcn_permlane32_swap(__float_as_uint(pmax), __float_as_uint(pmax), false, false);
    pmax = fmaxf(__uint_as_float(rr[0]), __uint_as_float(rr[1])); }
  if (__builtin_expect(__all(pmax - m_reg <= THR / SCALE), 1)) { mn = m_reg; alpha = 1.f; }
  else { mn = fmaxf(m_reg, pmax); alpha = __builtin_amdgcn_exp2f((m_reg - mn) * C); m_reg = mn; }
  float mnC = -mn * C;
#pragma unroll
  for (int r = 0; r < 16; ++r) p0[r] = fmaf(p0[r], C, mnC);
#pragma unroll
  for (int r = 0; r < 16; ++r) p1[r] = fmaf(p1[r], C, mnC);
#pragma unroll
  for (int r = 0; r < 16; ++r) p0[r] = __builtin_amdgcn_exp2f(p0[r]);
}
__device__ __forceinline__ void finishSM(f32x16& p0, f32x16& p1, float alpha, float& l_reg, bf16x8& pa0, bf16x8& pa1, bf16x8& pa2, bf16x8& pa3) {
#pragma unroll
  for (int r = 0; r < 16; ++r) p1[r] = __builtin_amdgcn_exp2f(p1[r]);
  float ps = 0;
#pragma unroll
  for (int r = 0; r < 16; ++r) ps += p0[r];
#pragma unroll
  for (int r = 0; r < 16; ++r) ps += p1[r];
  { auto rr = __builtin_amdgcn_permlane32_swap(__float_as_uint(ps), __float_as_uint(ps), false, false);
    ps = __uint_as_float(rr[0]) + __uint_as_float(rr[1]); }
  l_reg = l_reg * alpha + ps;
#define PK4(P, BASE, OUT) do { unsigned a0 = cvt_pk_bf16(P[BASE + 0], P[BASE + 1]), a1 = cvt_pk_bf16(P[BASE + 2], P[BASE + 3]);   \
    unsigned b0 = cvt_pk_bf16(P[BASE + 4], P[BASE + 5]), b1 = cvt_pk_bf16(P[BASE + 6], P[BASE + 7]);                              \
    auto r0 = __builtin_amdgcn_permlane32_swap(a0, b0, false, false); auto r1 = __builtin_amdgcn_permlane32_swap(a1, b1, false, false); \
    u32x4 w = {r0[0], r1[0], r0[1], r1[1]}; OUT = *reinterpret_cast<bf16x8*>(&w); } while (0)
  PK4(p0, 0, pa0); PK4(p0, 8, pa1); PK4(p1, 0, pa2); PK4(p1, 8, pa3);
#undef PK4
}
__device__ __forceinline__ void qkt(f32x16& p0, f32x16& p1, const bf16_t* Ks, const bf16x8* qr, int r32, int hi) {
  p0 = f32x16{}; p1 = f32x16{};
#pragma unroll
  for (int d0 = 0; d0 < 8; ++d0) { int cb = (d0 * 16 + hi * 8) * 2;
    bf16x8 b0 = *reinterpret_cast<const bf16x8*>((const char*)Ks + KSWZ(r32, cb));
    bf16x8 b1 = *reinterpret_cast<const bf16x8*>((const char*)Ks + KSWZ(32 + r32, cb));
    p0 = __builtin_amdgcn_mfma_f32_32x32x16_bf16(b0, qr[d0], p0, 0, 0, 0);
    p1 = __builtin_amdgcn_mfma_f32_32x32x16_bf16(b1, qr[d0], p1, 0, 0, 0); }
}
__device__ __forceinline__ int v_st(int k, int c) { const int kk = (k & ~0xC) | ((k & 4) << 1) | ((k & 8) >> 1); return ((kk >> 3) * 4 + (c >> 5)) * 512 + ((kk & 7) * 32 + (c & 31)) * 2; }
__device__ __forceinline__ int v_rd_base(int lane) { return ((lane & 3) << 3) | (((lane >> 2) & 3) << 6) | (((lane >> 4) & 1) << 5) | (((lane >> 5) & 1) << 8); }
constexpr int v_rd_off(int d0, int ks, int half) { return d0 * 512 + ks * 4096 + half * 2048; }
template <int OFF> __device__ __forceinline__ s16x4 tr_read(int vb) {
  s16x4 r; asm volatile("ds_read_b64_tr_b16 %0, %1 offset:%2" : "=&v"(r) : "v"(vb), "i"(OFF) : "memory"); return r;
}
template <int D0> __device__ __forceinline__ void pv_one(f32x16& od, int vb, bf16x8 pa0, bf16x8 pa1, bf16x8 pa2, bf16x8 pa3) {
  const s16x4 l0 = tr_read<v_rd_off(D0, 0, 0)>(vb), h0 = tr_read<v_rd_off(D0, 0, 1)>(vb), l1 = tr_read<v_rd_off(D0, 1, 0)>(vb), h1 = tr_read<v_rd_off(D0, 1, 1)>(vb);
  const s16x4 l2 = tr_read<v_rd_off(D0, 2, 0)>(vb), h2 = tr_read<v_rd_off(D0, 2, 1)>(vb), l3 = tr_read<v_rd_off(D0, 3, 0)>(vb), h3 = tr_read<v_rd_off(D0, 3, 1)>(vb);
  asm volatile("s_waitcnt lgkmcnt(0)" ::: "memory"); SBAR();
#define PK(L, H) (bf16x8){L[0], L[1], L[2], L[3], H[0], H[1], H[2], H[3]}
  od = __builtin_amdgcn_mfma_f32_32x32x16_bf16(pa0, PK(l0, h0), od, 0, 0, 0);
  od = __builtin_amdgcn_mfma_f32_32x32x16_bf16(pa1, PK(l1, h1), od, 0, 0, 0);
  od = __builtin_amdgcn_mfma_f32_32x32x16_bf16(pa2, PK(l2, h2), od, 0, 0, 0);
  od = __builtin_amdgcn_mfma_f32_32x32x16_bf16(pa3, PK(l3, h3), od, 0, 0, 0);
#undef PK
}
__device__ __forceinline__ void pv_d0(f32x16* o, int vb, bf16x8 pa0, bf16x8 pa1, bf16x8 pa2, bf16x8 pa3) {
  pv_one<0>(o[0], vb, pa0, pa1, pa2, pa3); pv_one<1>(o[1], vb, pa0, pa1, pa2, pa3); pv_one<2>(o[2], vb, pa0, pa1, pa2, pa3); pv_one<3>(o[3], vb, pa0, pa1, pa2, pa3);
}
struct NaCtx { int r, rs, c, cs, kr0; const LAS float* tbl; };
__device__ __forceinline__ void na_mask(f32x16& p0, f32x16& p1, const NaCtx& n, int tile, int hi) {
  const int kr = n.kr0 + tile; const bool vrow = (kr >= n.rs) && (kr < n.rs + 8);
  int dr = kr - n.r + 7; dr = dr < 0 ? 0 : (dr > 14 ? 14 : dr);
  const LAS float* t = n.tbl + dr * 32 + 15 - n.c;
  const float NEG = -INFINITY;
  const int d0 = 4 * hi - n.cs;
#pragma unroll
  for (int rr = 0; rr < 16; ++rr) { const int kq = (rr & 3) + 8 * (rr >> 2);
    const bool ok0 = vrow && ((unsigned)(kq + d0) < 16u), ok1 = vrow && ((unsigned)(kq + 32 + d0) < 16u);
    const float b0 = t[kq + 4 * hi], b1 = t[kq + 4 * hi + 32];
    p0[rr] = ok0 ? p0[rr] + b0 : NEG; p1[rr] = ok1 ? p1[rr] + b1 : NEG;
    if ((rr & 3) == 3) asm volatile("" ::: "memory"); }
}

template <int LDQ, int LDK, int LDO, bool NA, int OSH = -1>
__device__ __forceinline__ void attn_body(const bf16_t* Qb, const bf16_t* __restrict__ Kh, const bf16_t* __restrict__ Vh, bf16_t* Ob, int seq, char* lds, const NaCtx& na) {
  int tid_ = threadIdx.x; asm volatile("" : "+v"(tid_));
  const int tid = tid_, wid = tid >> 6, lane = tid & 63, r32 = lane & 31, hi = lane >> 5;
  bf16_t* V_lds = (bf16_t*)lds; bf16_t* K_lds = (bf16_t*)(lds + 2 * SHM_V);
  float* ws = (float*)(lds + 2 * SHM_V + 2 * SHM_K) + wid * 64; float* li_l = ws; float* al_l = ws + 32;
  float m_reg = -1e30f, l_reg = 0; f32x16 o[4] = {}; bf16x8 qr[8];
  const bf16_t* Qw = Qb + (long)(wid * QBLK + r32) * LDQ + hi * 8;
#pragma unroll
  for (int d0 = 0; d0 < 8; ++d0) qr[d0] = ld8(Qw + d0 * 16);
  const int sr = tid >> 4, sc = (tid & 15) * 8, vst0 = v_st(sr, sc), vst1 = v_st(32 + sr, sc);
  const int vb0 = (int)(uintptr_t)V_lds + v_rd_base(lane);
  struct { bf16x8 vs0, vs1, ks0, ks1; } sr_[2];
#define SLOAD(i, k0) do { sr_[i].vs0 = ld8(&Vh[(long)((k0) + sr) * LDK + sc]); sr_[i].vs1 = ld8(&Vh[(long)((k0) + 32 + sr) * LDK + sc]); \
    sr_[i].ks0 = ld8(&Kh[(long)((k0) + sr) * LDK + sc]); sr_[i].ks1 = ld8(&Kh[(long)((k0) + 32 + sr) * LDK + sc]); } while (0)
#define SWRITE(b, i) do { *(bf16x8*)((char*)V_lds + (b) * SHM_V + vst0) = sr_[i].vs0;          \
    *(bf16x8*)((char*)V_lds + (b) * SHM_V + vst1) = sr_[i].vs1; int kc = sc * 2;               \
    *(bf16x8*)((char*)K_lds + (b) * SHM_K + KSWZ(sr, kc)) = sr_[i].ks0;                       \
    *(bf16x8*)((char*)K_lds + (b) * SHM_K + KSWZ(32 + sr, kc)) = sr_[i].ks1; } while (0)
#define SWAIT() asm volatile("s_waitcnt vmcnt(4)" ::: "memory")
#define RESC(a) do { if (__any((a) < 1.f)) { if (hi == 0) al_l[r32] = (a); asm volatile("s_waitcnt lgkmcnt(0)" ::: "memory"); \
    _Pragma("unroll") for (int d = 0; d < 4; ++d) _Pragma("unroll") for (int r = 0; r < 16; ++r) o[d][r] *= al_l[crow(r, hi)]; } } while (0)
#define NAM(P0, P1, t) do { if constexpr (NA) { SBAR(); na_mask(P0, P1, na, (t), hi); SBAR(); } } while (0)
  f32x16 pA0, pA1, pB0, pB1; float mnA, mnB, alA, alB; bf16x8 pa0, pa1, pa2, pa3; const int NT = seq / KVBLK;
  constexpr int SE = 0, SO = 1;
  SLOAD(SE, 0); asm volatile("s_waitcnt vmcnt(0)" ::: "memory"); SWRITE(0, SE); __syncthreads();
  qkt(pA0, pA1, K_lds, qr, r32, hi); NAM(pA0, pA1, 0); partialSM(pA0, pA1, m_reg, mnA, alA);
  SLOAD(SO, KVBLK); if (2 < NT) SLOAD(SE, 2 * KVBLK);
  SWAIT(); SWRITE(1, SO); __syncthreads();
  for (int j = 1; j + 1 < NT; j += 2) {
    SBAR(); qkt(pB0, pB1, (bf16_t*)((char*)K_lds + SHM_K), qr, r32, hi);
    finishSM(pA0, pA1, alA, l_reg, pa0, pa1, pa2, pa3); SBAR();
    SLOAD(SO, (j + 2) * KVBLK); SBAR();
    pv_d0(o, vb0, pa0, pa1, pa2, pa3); NAM(pB0, pB1, j); partialSM(pB0, pB1, m_reg, mnB, alB);
    __syncthreads(); SWAIT(); SWRITE(0, SE);
    RESC(alB); __syncthreads();
    SBAR(); qkt(pA0, pA1, K_lds, qr, r32, hi);
    finishSM(pB0, pB1, alB, l_reg, pa0, pa1, pa2, pa3); SBAR();
    if (j + 3 < NT) SLOAD(SE, (j + 3) * KVBLK); SBAR();
    pv_d0(o, vb0 + (int)SHM_V, pa0, pa1, pa2, pa3); NAM(pA0, pA1, j + 1); partialSM(pA0, pA1, m_reg, mnA, alA);
    __syncthreads(); SWAIT(); SWRITE(1, SO);
    RESC(alA); __syncthreads();
  }
  SBAR(); qkt(pB0, pB1, (bf16_t*)((char*)K_lds + SHM_K), qr, r32, hi);
  finishSM(pA0, pA1, alA, l_reg, pa0, pa1, pa2, pa3); SBAR();
  pv_d0(o, vb0, pa0, pa1, pa2, pa3); NAM(pB0, pB1, NT - 1); partialSM(pB0, pB1, m_reg, mnB, alB);
  __syncthreads(); RESC(alB);
  finishSM(pB0, pB1, alB, l_reg, pa0, pa1, pa2, pa3); SBAR();
  pv_d0(o, vb0 + (int)SHM_V, pa0, pa1, pa2, pa3);
  if (hi == 0) li_l[r32] = l_reg; asm volatile("s_waitcnt lgkmcnt(0)" ::: "memory");
  float rli[16];
#pragma unroll
  for (int r = 0; r < 16; ++r) rli[r] = __builtin_amdgcn_rcpf(li_l[crow(r, hi)]);
  if constexpr (OSH >= 0) {
    unsigned char* Ow8 = (unsigned char*)Ob + (long)(wid * QBLK) * LDO;
#pragma unroll
    for (int r = 0; r < 16; ++r) { int orow = crow(r, hi); const float sc = rli[r] * (float)(1 << (OSH >= 0 ? OSH : 0));
#pragma unroll
      for (int d0 = 0; d0 < 4; ++d0) Ow8[(long)orow * LDO + d0 * 32 + r32] = (unsigned char)(__builtin_amdgcn_cvt_pk_fp8_f32(o[d0][r] * sc, 0.f, 0, false) & 0xff); }
  } else {
  bf16_t* Ow = Ob + (long)(wid * QBLK) * LDO;
#pragma unroll
  for (int r = 0; r < 16; ++r) { int orow = crow(r, hi);
#pragma unroll
    for (int d0 = 0; d0 < 4; ++d0) Ow[(long)orow * LDO + d0 * 32 + r32] = (bf16_t)(cvt_pk_bf16(o[d0][r] * rli[r], 0.f) & 0xffffu); }
  }
#undef SLOAD
#undef SWRITE
#undef SWAIT
#undef RESC
#undef NAM
}

__device__ __forceinline__ int vt_pos(int l) { const int kk = l & 31; return 32 * ((l >> 2) & 1) + (kk & 3) + 4 * (kk >> 3) + 16 * (l >> 5); }
#define F8_MFMA(A, B, C) __builtin_amdgcn_mfma_scale_f32_32x32x64_f8f6f4(A, B, C, 0, 0, 0, 0x7f7f7f7f, 0, 0x7f7f7f7f)
#define F8_MFMA_QK(A, B, C) __builtin_amdgcn_mfma_scale_f32_32x32x64_f8f6f4(A, B, C, 0, 0, 0, 0x7f7f7f7f, 0, 0x7c7c7c7c)
constexpr float QPRE = SCALE * 1.4426950408889634f * 8.0f;
template <int THRV>
__device__ __forceinline__ void partialSM8(f32x16& p0, f32x16& p1, float& m_reg, float& mn, float& alpha) {
  constexpr float THR2 = (float)THRV * 1.4426950408889634f;
  float pmax = p0[0];
#pragma unroll
  for (int r = 1; r < 16; ++r) pmax = fmaxf(pmax, p0[r]);
#pragma unroll
  for (int r = 0; r < 16; ++r) pmax = fmaxf(pmax, p1[r]);
  { auto rr = __builtin_amdgcn_permlane32_swap(__float_as_uint(pmax), __float_as_uint(pmax), false, false);
    pmax = fmaxf(__uint_as_float(rr[0]), __uint_as_float(rr[1])); }
  if (__builtin_expect(__all(pmax - m_reg <= THR2), 1)) { mn = m_reg; alpha = 1.f; }
  else { mn = fmaxf(m_reg, pmax); alpha = __builtin_amdgcn_exp2f(m_reg - mn); m_reg = mn; }
  p0 = p0 - mn; p1 = p1 - mn;
#pragma unroll
  for (int r = 0; r < 16; ++r) p0[r] = __builtin_amdgcn_exp2f(p0[r]);
}
#define F8_CAT(lo, hi) __builtin_shufflevector(lo, hi, 0, 1, 2, 3, 4, 5, 6, 7)
__device__ __forceinline__ void qkt8(f32x16& p0, f32x16& p1, const char* Ks, const i32x8* q8, int r32, int hi) {
  const int g = (r32 >> 1) & 7;
  const char* k0 = Ks + r32 * 128; const char* k1 = k0 + 32 * 128;
#pragma unroll
  for (int j = 0; j < 2; ++j) { const int c0 = 4 * j + 2 * hi;
    const i32x8 a0 = F8_CAT(*(const i32x4*)(k0 + (((c0) ^ g) << 4)), *(const i32x4*)(k0 + (((c0 + 1) ^ g) << 4)));
    const i32x8 a1 = F8_CAT(*(const i32x4*)(k1 + (((c0) ^ g) << 4)), *(const i32x4*)(k1 + (((c0 + 1) ^ g) << 4)));
    if (j == 0) { p0 = F8_MFMA_QK(a0, q8[0], f32x16{}); p1 = F8_MFMA_QK(a1, q8[0], f32x16{}); }
    else { p0 = F8_MFMA_QK(a0, q8[1], p0); p1 = F8_MFMA_QK(a1, q8[1], p1); } }
}
__device__ __forceinline__ void pv8(f32x16* o, const char* Vs, i32x8 pa, int r32, int hi) {
#pragma unroll
  for (int db = 0; db < 4; ++db) { const int d = 32 * db + r32, f = (d >> 2) & 3; const char* vr = Vs + d * 64;
    const i32x8 b = F8_CAT(*(const i32x4*)(vr + (((2 * hi) ^ f) << 4)), *(const i32x4*)(vr + (((2 * hi + 1) ^ f) << 4)));
    o[db] = F8_MFMA(pa, b, o[db]); }
}
__device__ __forceinline__ void finishSM8(f32x16& p0, f32x16& p1, float alpha, float& l_reg, i32x8& pa) {
#pragma unroll
  for (int r = 0; r < 16; ++r) p1[r] = __builtin_amdgcn_exp2f(p1[r]);
  float ps;
  { typedef float f32x8_ __attribute__((ext_vector_type(8)));
    const f32x16 t = p0 + p1;
    const f32x8_ t8 = __builtin_shufflevector(t, t, 0, 1, 2, 3, 4, 5, 6, 7) + __builtin_shufflevector(t, t, 8, 9, 10, 11, 12, 13, 14, 15);
    const f32x4 t4 = __builtin_shufflevector(t8, t8, 0, 1, 2, 3) + __builtin_shufflevector(t8, t8, 4, 5, 6, 7);
    const f32x2 t2 = __builtin_shufflevector(t4, t4, 0, 1) + __builtin_shufflevector(t4, t4, 2, 3);
    ps = t2.x + t2.y; }
  { auto rr = __builtin_amdgcn_permlane32_swap(__float_as_uint(ps), __float_as_uint(ps), false, false);
    ps = __uint_as_float(rr[0]) + __uint_as_float(rr[1]); }
  l_reg = l_reg * alpha + ps;
#pragma unroll
  for (int w = 0; w < 4; ++w) { pa[w] = (int)pack4_fp8(p0[4 * w], p0[4 * w + 1], p0[4 * w + 2], p0[4 * w + 3]); pa[4 + w] = (int)pack4_fp8(p1[4 * w], p1[4 * w + 1], p1[4 * w + 2], p1[4 * w + 3]); }
}
constexpr int F8_KB = 8192, F8_LDS_V = 2 * F8_KB, F8_LDS_WS = 4 * F8_KB;
template <int LDQ, int LDK, int LDO, int OSH>
__device__ __forceinline__ void attn_body_f8(const unsigned char* Qb, const unsigned char* __restrict__ Kh, const unsigned char* __restrict__ VTh, long ldv, unsigned char* Ob, int seq, char* lds) {
  int tid_ = threadIdx.x; asm volatile("" : "+v"(tid_));
  const int tid = tid_, wid = tid >> 6, lane = tid & 63, r32 = lane & 31, hi = lane >> 5;
  char* K_lds = lds; char* V_lds = lds + F8_LDS_V;
  float* ws = (float*)(lds + F8_LDS_WS) + wid * 64; float* li_l = ws; float* al_l = ws + 32;
  float m_reg = -1e30f, l_reg = 0; f32x16 o[4] = {}; i32x8 q8[2];
  { const unsigned char* Qw = Qb + (long)(wid * QBLK + r32) * LDQ + 32 * hi;
#pragma unroll
    for (int j = 0; j < 2; ++j) q8[j] = F8_CAT(*(const i32x4*)(Qw + 64 * j), *(const i32x4*)(Qw + 64 * j + 16)); }
  const int krow = tid >> 3, kc = tid & 7, kst = krow * 128 + ((kc ^ ((krow >> 1) & 7)) << 4);
  const int vd = tid >> 2, vc = tid & 3, vst = vd * 64 + ((vc ^ ((vd >> 2) & 3)) << 4);
  const unsigned char* kg = Kh + (long)krow * LDK + 16 * kc; const unsigned char* vg = VTh + (long)vd * ldv + 16 * vc;
  struct { i32x4 ks, vs; } sr_[2];
#define SLOAD(i, k0) do { sr_[i].ks = *(const i32x4*)(kg + (long)(k0) * LDK); sr_[i].vs = *(const i32x4*)(vg + (k0)); } while (0)
#define SWRITE(b, i) do { *(i32x4*)(K_lds + (b) * F8_KB + kst) = sr_[i].ks; *(i32x4*)(V_lds + (b) * F8_KB + vst) = sr_[i].vs; } while (0)
#define SWAIT() asm volatile("s_waitcnt vmcnt(2)" ::: "memory")
#define RESC(a) do { if (__any((a) < 1.f)) { if (hi == 0) al_l[r32] = (a); asm volatile("s_waitcnt lgkmcnt(0)" ::: "memory"); \
    _Pragma("unroll") for (int d = 0; d < 4; ++d) _Pragma("unroll") for (int r = 0; r < 16; ++r) o[d][r] *= al_l[crow(r, hi)]; } } while (0)
#define PV8(b, pa) do { asm volatile("s_waitcnt lgkmcnt(0)" ::: "memory"); pv8(o, V_lds + (b) * F8_KB, pa, r32, hi); } while (0)
  f32x16 pA0, pA1, pB0, pB1; float mnA, mnB, alA, alB; i32x8 pa; const int NT = seq / KVBLK;
  if (wid >= 4) __builtin_amdgcn_s_setprio(1);
  constexpr int SE = 0, SO = 1;
  SLOAD(SE, 0); asm volatile("s_waitcnt vmcnt(0)" ::: "memory"); SWRITE(0, SE); __syncthreads();
  qkt8(pA0, pA1, K_lds, q8, r32, hi); partialSM8<5>(pA0, pA1, m_reg, mnA, alA);
  SLOAD(SO, KVBLK); if (2 < NT) SLOAD(SE, 2 * KVBLK);
  SWAIT(); SWRITE(1, SO); __syncthreads();
  for (int j = 1; j + 1 < NT; j += 2) {
    SBAR(); qkt8(pB0, pB1, K_lds + F8_KB, q8, r32, hi);
    finishSM8(pA0, pA1, alA, l_reg, pa); SBAR();
    SLOAD(SO, (j + 2) * KVBLK); SBAR();
    PV8(0, pa); partialSM8<5>(pB0, pB1, m_reg, mnB, alB);
    __syncthreads(); SWAIT(); SWRITE(0, SE);
    RESC(alB); __syncthreads();
    SBAR(); qkt8(pA0, pA1, K_lds, q8, r32, hi);
    finishSM8(pB0, pB1, alB, l_reg, pa); SBAR();
    if (j + 3 < NT) SLOAD(SE, (j + 3) * KVBLK); SBAR();
    PV8(1, pa); partialSM8<5>(pA0, pA1, m_reg, mnA, alA);
    __syncthreads(); SWAIT(); SWRITE(1, SO);
    RESC(alA); __syncthreads();
  }
  SBAR(); qkt8(pB0, pB1, K_lds + F8_KB, q8, r32, hi);
  finishSM8(pA0, pA1, alA, l_reg, pa); SBAR();
  PV8(0, pa); partialSM8<5>(pB0, pB1, m_reg, mnB, alB);
  __syncthreads(); RESC(alB);
  finishSM8(pB0, pB1, alB, l_reg, pa); SBAR();
  PV8(1, pa);
  if (hi == 0) li_l[r32] = l_reg; asm volatile("s_waitcnt lgkmcnt(0)" ::: "memory");
  float rli[16];
#pragma unroll
  for (int r = 0; r < 16; ++r) rli[r] = __builtin_amdgcn_rcpf(li_l[crow(r, hi)]);
  unsigned char* Ow8 = Ob + (long)(wid * QBLK) * LDO;
#pragma unroll
  for (int r = 0; r < 16; ++r) { int orow = crow(r, hi); const float sc = rli[r] * (float)(1 << OSH);
#pragma unroll
    for (int d0 = 0; d0 < 4; ++d0) Ow8[(long)orow * LDO + d0 * 32 + r32] = (unsigned char)(__builtin_amdgcn_cvt_pk_fp8_f32(o[d0][r] * sc, 0.f, 0, false) & 0xff); }
  __builtin_amdgcn_s_setprio(0);
#undef SLOAD
#undef SWRITE
#undef SWAIT
#undef RESC
#undef PV8
}
#undef F8_MFMA
#undef F8_MFMA_QK
#undef F8_CAT
#undef SBAR
}

constexpr int NWAVES = 8;
constexpr int LDS_BYTES = 135168;
static_assert(att::ATT_LDS <= LDS_BYTES && pg8::STAGE_BYTES <= LDS_BYTES, "LDS map");
constexpr int NPH = 1 + 5 * NCH + 3 + 2 * NCH + 1;

struct Args { const float* in[21]; float* out; unsigned char* ws; int ph_lo, ph_hi; };

__device__ __forceinline__ float wave_sum(float v) {
#pragma unroll
    for (int o = 1; o < 64; o <<= 1) v += __shfl_xor(v, o);
    return v;
}
__device__ __forceinline__ void transpose_item(const float* __restrict__ W, int K, int N, bf16_t* __restrict__ WT, const float* __restrict__ gain, LAS float* scr, int item, int lane) {
    const int nblk = N / 32, kb = item / nblk, nb = item % nblk, k0 = 64 * kb, n0 = 32 * nb;
    { const int kr = lane >> 3, n4 = (lane & 7) * 4; f32x4 w[8];
#pragma unroll
      for (int i = 0; i < 8; ++i) w[i] = *(const f32x4*)(W + (size_t)(k0 + 8 * i + kr) * N + n0 + n4);
#pragma unroll
      for (int i = 0; i < 8; ++i) { const int kk = 8 * i + kr; f32x4 v = w[i]; if (gain) v = v * gain[k0 + kk]; LAS float* d = scr + kk * 33 + n4; d[0] = v.x; d[1] = v.y; d[2] = v.z; d[3] = v.w; } }
    asm volatile("s_waitcnt lgkmcnt(0)" ::: "memory");
    const int c = lane & 7;
#pragma unroll
    for (int j = 0; j < 4; ++j) { const int n = (lane >> 3) + 8 * j; const LAS float* s = scr + (8 * c) * 33 + n;
        u32x4 o; o.x = cvt_pk_bf16(s[0 * 33], s[1 * 33]); o.y = cvt_pk_bf16(s[2 * 33], s[3 * 33]); o.z = cvt_pk_bf16(s[4 * 33], s[5 * 33]); o.w = cvt_pk_bf16(s[6 * 33], s[7 * 33]);
        *(u32x4*)(WT + (size_t)(n0 + n) * K + k0 + 8 * c) = o; }
    asm volatile("s_waitcnt lgkmcnt(0)" ::: "memory");
}
__device__ __forceinline__ void transpose_item_fp8(const float* __restrict__ W, int K, int N, unsigned char* __restrict__ WT, const float* __restrict__ gain, float mul, LAS float* scr, int item, int lane) {
    const int nblk = N / 32, kb = item / nblk, nb = item % nblk, k0 = 64 * kb, n0 = 32 * nb;
    { const int kr = lane >> 3, n4 = (lane & 7) * 4; f32x4 w[8];
#pragma unroll
      for (int i = 0; i < 8; ++i) w[i] = *(const f32x4*)(W + (size_t)(k0 + 8 * i + kr) * N + n0 + n4);
#pragma unroll
      for (int i = 0; i < 8; ++i) { const int kk = 8 * i + kr; f32x4 v = w[i] * mul; if (gain) v = v * gain[k0 + kk]; LAS float* d = scr + kk * 33 + n4; d[0] = v.x; d[1] = v.y; d[2] = v.z; d[3] = v.w; } }
    asm volatile("s_waitcnt lgkmcnt(0)" ::: "memory");
    const int c = lane & 3;
#pragma unroll
    for (int j = 0; j < 2; ++j) { const int n = (lane >> 2) + 16 * j; const LAS float* s = scr + (16 * c) * 33 + n;
        u32x4 o; o.x = pack4_fp8(s[0 * 33], s[1 * 33], s[2 * 33], s[3 * 33]); o.y = pack4_fp8(s[4 * 33], s[5 * 33], s[6 * 33], s[7 * 33]);
        o.z = pack4_fp8(s[8 * 33], s[9 * 33], s[10 * 33], s[11 * 33]); o.w = pack4_fp8(s[12 * 33], s[13 * 33], s[14 * 33], s[15 * 33]);
        *(u32x4*)(WT + (size_t)(n0 + n) * K + k0 + 16 * c) = o; }
    asm volatile("s_waitcnt lgkmcnt(0)" ::: "memory");
}
__device__ __forceinline__ void rms_row_to_fp8(const float* xrow, unsigned char* orow, int lane) {
    const f32x4* xr = (const f32x4*)xrow + lane;
    f32x4 v[8]; float s = 0.f;
#pragma unroll
    for (int j = 0; j < 8; ++j) { v[j] = xr[64 * j]; s += (v[j].x * v[j].x + v[j].y * v[j].y) + (v[j].z * v[j].z + v[j].w * v[j].w); }
    const float rr = __builtin_amdgcn_rsqf(wave_sum(s) * (1.f / DM) + EPS);
    unsigned* o4 = (unsigned*)orow + lane;
#pragma unroll
    for (int j = 0; j < 8; ++j) o4[64 * j] = pack4_fp8(v[j].x * rr, v[j].y * rr, v[j].z * rr, v[j].w * rr);
}
__device__ __forceinline__ void rms_row2_to_fp8(const float* xa, const float* xb, unsigned char* oa, unsigned char* ob, int lane) {
    const f32x4* pa = (const f32x4*)xa + lane; const f32x4* pb = (const f32x4*)xb + lane;
    f32x4 va[8], vb[8]; float sa = 0.f, sb = 0.f;
#pragma unroll
    for (int j = 0; j < 8; ++j) { va[j] = pa[64 * j]; vb[j] = pb[64 * j]; }
#pragma unroll
    for (int j = 0; j < 8; ++j) { sa += (va[j].x * va[j].x + va[j].y * va[j].y) + (va[j].z * va[j].z + va[j].w * va[j].w); sb += (vb[j].x * vb[j].x + vb[j].y * vb[j].y) + (vb[j].z * vb[j].z + vb[j].w * vb[j].w); }
    const float ra = __builtin_amdgcn_rsqf(wave_sum(sa) * (1.f / DM) + EPS), rb = __builtin_amdgcn_rsqf(wave_sum(sb) * (1.f / DM) + EPS);
    unsigned* qa = (unsigned*)oa + lane; unsigned* qb = (unsigned*)ob + lane;
#pragma unroll
    for (int j = 0; j < 8; ++j) { qa[64 * j] = pack4_fp8(va[j].x * ra, va[j].y * ra, va[j].z * ra, va[j].w * ra); qb[64 * j] = pack4_fp8(vb[j].x * rb, vb[j].y * rb, vb[j].z * rb, vb[j].w * rb); }
}
__device__ __forceinline__ void rms_row_to_bf16(const float* xrow, bf16_t* orow, int lane) {
    const f32x4* xr = (const f32x4*)xrow + lane;
    f32x4 v[8]; float s = 0.f;
#pragma unroll
    for (int j = 0; j < 8; ++j) { v[j] = xr[64 * j]; s += (v[j].x * v[j].x + v[j].y * v[j].y) + (v[j].z * v[j].z + v[j].w * v[j].w); }
    const float rr = __builtin_amdgcn_rsqf(wave_sum(s) * (1.f / DM) + EPS);
    u32x2* o8 = (u32x2*)orow + lane;
#pragma unroll
    for (int j = 0; j < 8; ++j) { u32x2 w; w.x = cvt_pk_bf16(v[j].x * rr, v[j].y * rr); w.y = cvt_pk_bf16(v[j].z * rr, v[j].w * rr); o8[64 * j] = w; }
}
__device__ __forceinline__ u32x4 rope_item(const u32x4 raw, const size_t e0, int W, int seq, const float* __restrict__ g, float mul) {
    const int tok = (int)(e0 / (size_t)W), d = (int)(e0 & 127);
    float x[8] = {bf_lo(raw.x), bf_hi(raw.x), bf_lo(raw.y), bf_hi(raw.y), bf_lo(raw.z), bf_hi(raw.z), bf_lo(raw.w), bf_hi(raw.w)};
    float ssq = 0.f;
#pragma unroll
    for (int e = 0; e < 8; ++e) ssq += x[e] * x[e];
    ssq += __shfl_xor(ssq, 1); ssq += __shfl_xor(ssq, 2); ssq += __shfl_xor(ssq, 4); ssq += __shfl_xor(ssq, 8);
    const float rr = __builtin_amdgcn_rsqf(ssq * (1.f / 128.f) + EPS);
    const f32x4 g0 = *(const f32x4*)(g + d), g1 = *(const f32x4*)(g + d + 4);
    x[0] *= rr * g0.x; x[1] *= rr * g0.y; x[2] *= rr * g0.z; x[3] *= rr * g0.w; x[4] *= rr * g1.x; x[5] *= rr * g1.y; x[6] *= rr * g1.z; x[7] *= rr * g1.w;
    const int s = tok % seq; const float pos = (float)((d < 64) ? (s >> 6) : (s & 63));
    const bool first = ((d & 63) < 32); const int fi0 = d & 31;
    float y[8];
#pragma unroll
    for (int e = 0; e < 8; ++e) { const float other = __shfl_xor(x[e], 4);
        const float invf = __builtin_amdgcn_exp2f(-(float)(fi0 + e) * 0.41524101186092029f);
        float rev = pos * invf * 0.15915494309189535f; rev -= rintf(rev);
        const float sn = __builtin_amdgcn_sinf(rev), cs = __builtin_amdgcn_cosf(rev);
        y[e] = (first ? (x[e] * cs - other * sn) : (x[e] * cs + other * sn)) * mul; }
    u32x4 w; w.x = pack4_fp8(y[0], y[1], y[2], y[3]); w.y = pack4_fp8(y[4], y[5], y[6], y[7]); w.z = 0u; w.w = 0u;
    return w;
}
__device__ __forceinline__ void rope_pass(const bf16_t* buf, unsigned char* out8, int W, int ntok, int seq, const float* __restrict__ g, float mul, int gw, int ngw, int lane) {
    const int nitems = (int)(((size_t)ntok * W) / 512);
    for (int it = gw; it < nitems; it += 4 * ngw) {
        size_t e[4]; u32x4 raw[4];
#pragma unroll
        for (int q = 0; q < 4; ++q) { const int iq = it + q * ngw; e[q] = (size_t)(iq < nitems ? iq : it) * 512 + (size_t)lane * 8; raw[q] = *(const u32x4*)(buf + e[q]); }
#pragma unroll
        for (int q = 0; q < 4; ++q) { const u32x4 w = rope_item(raw[q], e[q], W, seq, g, mul); if (it + q * ngw < nitems) { u32x2 o; o.x = w.x; o.y = w.y; *(u32x2*)(out8 + e[q]) = o; } }
    }
}
__device__ __forceinline__ void vt_pass(const bf16_t* gv, unsigned char* VT8, int ntok, int seq, int gw, int ngw, int lane) {
    const int nitems = (ntok / 64) * 2;
    for (int it = gw; it < nitems; it += ngw) {
        const int blk = it >> 1, kvh = it & 1, tok0 = blk * 64, b = tok0 / seq, s0 = tok0 % seq;
        const bf16_t* src = gv + (size_t)(tok0 + lane) * 256 + kvh * 128;
        unsigned char* dst = VT8 + ((size_t)(b * 2 + kvh) * 128) * (size_t)seq + s0 + att::vt_pos(lane);
        u32x4 raw[16];
#pragma unroll
        for (int c = 0; c < 16; ++c) raw[c] = *(const u32x4*)(src + 8 * c);
#pragma unroll
        for (int c = 0; c < 16; ++c) {
            const unsigned a = pack4_fp8(bf_lo(raw[c].x), bf_hi(raw[c].x), bf_lo(raw[c].y), bf_hi(raw[c].y)), d2 = pack4_fp8(bf_lo(raw[c].z), bf_hi(raw[c].z), bf_lo(raw[c].w), bf_hi(raw[c].w));
            unsigned char* dp = dst + (size_t)(8 * c) * seq;
            dp[0] = (unsigned char)(a & 0xff); dp[(size_t)seq] = (unsigned char)((a >> 8) & 0xff); dp[2 * (size_t)seq] = (unsigned char)((a >> 16) & 0xff); dp[3 * (size_t)seq] = (unsigned char)(a >> 24);
            dp[4 * (size_t)seq] = (unsigned char)(d2 & 0xff); dp[5 * (size_t)seq] = (unsigned char)((d2 >> 8) & 0xff); dp[6 * (size_t)seq] = (unsigned char)((d2 >> 16) & 0xff); dp[7 * (size_t)seq] = (unsigned char)(d2 >> 24); }
    }
}

#define XB_TMO      128
#define XB_XCNT(j)  (256  + 64 * (j))
#define XB_XSUB(j)  (1280 + 64 * (j))
#define XB_XGEN(j)  (2304 + 64 * (j))
#define XB_TOP      3328
#define XB_TOPGEN   3392
#define XCD_BAR_WORDS 3456
#define XB_SPIN_CAP (1u << 20)
__device__ __forceinline__ unsigned xb_ld(unsigned* p)              { return __hip_atomic_load(p, __ATOMIC_RELAXED, __HIP_MEMORY_SCOPE_AGENT); }
__device__ __forceinline__ unsigned xb_add(unsigned* p, unsigned v) { return __hip_atomic_fetch_add(p, v, __ATOMIC_RELAXED, __HIP_MEMORY_SCOPE_AGENT); }
__device__ __forceinline__ unsigned xb_xcc_id() { return (unsigned)__builtin_amdgcn_s_getreg((3 << 11) | 20) & 0xFu; }
#define XB_SPIN(cond, bar) do { unsigned _sp = 0; while (cond) { __builtin_amdgcn_s_sleep(1); \
    if ((++_sp & 255u) == 0u) { if (xb_ld(&(bar)[XB_TMO])) break; if (_sp > XB_SPIN_CAP) { atomicAdd(&(bar)[XB_TMO], 1u); break; } } } } while (0)
struct XcdBarrier { unsigned* bar; unsigned x; volatile LAS unsigned* st; };
__device__ __forceinline__ XcdBarrier xcd_barrier_post(unsigned* bar, volatile LAS unsigned* st) {
    XcdBarrier b; b.bar = bar; b.x = xb_xcc_id(); b.st = st;
    if (threadIdx.x == 0) (void)xb_add(&bar[XB_XCNT(b.x)], 1u);
    return b;
}
__device__ __forceinline__ void xcd_barrier_complete(unsigned* bar, unsigned x, unsigned& nloc, unsigned& nx) {
    const unsigned G = gridDim.x * gridDim.y * gridDim.z;
    unsigned sum, cnt, mine, sp = 0u;
    for (;;) {
        sum = 0u; cnt = 0u; mine = 0u;
#pragma unroll
        for (unsigned j = 0; j < 16; ++j) { const unsigned c = xb_ld(&bar[XB_XCNT(j)]); sum += c; cnt += (c > 0u) ? 1u : 0u; mine = (j == x) ? c : mine; }
        if (sum == G) break;
        __builtin_amdgcn_s_sleep(1);
        if ((++sp & 255u) == 0u) { if (xb_ld(&bar[XB_TMO])) break; if (sp > XB_SPIN_CAP) { atomicAdd(&bar[XB_TMO], 1u); break; } }
    }
    nloc = mine > 0u ? mine : 1u; nx = cnt > 0u ? cnt : 1u;
}
__device__ __forceinline__ void xcd_barrier(const XcdBarrier& b) {
    asm volatile("s_waitcnt vmcnt(0)" ::: "memory");
    __syncthreads();
    if (threadIdx.x == 0) {
        unsigned* bar = b.bar;
        __builtin_amdgcn_s_waitcnt(0);
        unsigned nloc = b.st[0], nx = b.st[1];
        if (nloc == 0u) { xcd_barrier_complete(bar, b.x, nloc, nx); b.st[0] = nloc; b.st[1] = nx; }
        const unsigned old = xb_add(&bar[XB_XSUB(b.x)], 1u);
        const unsigned gen = old / nloc;
        if (old + 1u == (gen + 1u) * nloc) {
            __builtin_amdgcn_fence(__ATOMIC_RELEASE, "agent");
            asm volatile("s_waitcnt vmcnt(0)" ::: "memory");
            const unsigned og = xb_add(&bar[XB_TOP], 1u);
            const unsigned tg = og / nx;
            if (og + 1u == (tg + 1u) * nx) xb_add(&bar[XB_TOPGEN], 1u);
            else XB_SPIN(xb_ld(&bar[XB_TOPGEN]) == tg, bar);
            __builtin_amdgcn_fence(__ATOMIC_ACQUIRE, "agent");
            xb_add(&bar[XB_XGEN(b.x)], 1u);
            asm volatile("s_waitcnt vmcnt(0)" ::: "memory");
        } else {
            XB_SPIN(xb_ld(&bar[XB_XGEN(b.x)]) == gen, bar);
            __builtin_amdgcn_fence(__ATOMIC_ACQUIRE, "agent");
            asm volatile("s_waitcnt vmcnt(0)" ::: "memory");
        }
    }
    __syncthreads();
}
constexpr size_t WS_BAR = 655360;
constexpr int LDS_MISC_OFF = 131072 + 2048;
static_assert(WS_BAR >= 3 * (size_t)NTOK * 4 && WS_BAR + XCD_BAR_WORDS * 4 <= WS_WIN && LDS_MISC_OFF + 16 <= LDS_BYTES, "barrier words");
__device__ __forceinline__ void ti_set(const float*& t_src, int& t_ldw, int& t_K, int& t_k0, int& t_n0, int& t_kind, const float*& t_gain, float& t_mul, unsigned char*& t_dst, const float* W, int K, int N, void* WT, const float* gain, float mul, int kind, int r) {
    const int nblk = N / 32, kb = r / nblk, nb = r % nblk; t_src = W; t_ldw = N; t_K = K; t_k0 = 64 * kb; t_n0 = 32 * nb; t_kind = kind; t_gain = gain; t_mul = mul; t_dst = (unsigned char*)WT;
}
__device__ __forceinline__ void ti_load(f32x4 (&t_w)[8], const float* t_src, int t_ldw, int t_k0, int t_n0, int lane) {
    const int kr = lane >> 3, n4 = (lane & 7) * 4;
#pragma unroll
    for (int i = 0; i < 8; ++i) t_w[i] = *(const f32x4*)(t_src + (size_t)(t_k0 + 8 * i + kr) * t_ldw + t_n0 + n4);
}
__device__ __forceinline__ void ti_process(const f32x4 (&t_w)[8], int t_K, int t_k0, int t_n0, int t_kind, const float* t_gain, float t_mul, unsigned char* t_dst, LAS float* scr, int lane) {
    { const int kr = lane >> 3, n4 = (lane & 7) * 4;
#pragma unroll
      for (int i = 0; i < 8; ++i) { const int kk = 8 * i + kr; f32x4 v = t_w[i] * t_mul; if (t_gain) v = v * t_gain[t_k0 + kk]; LAS float* d = scr + kk * 33 + n4; d[0] = v.x; d[1] = v.y; d[2] = v.z; d[3] = v.w; } }
    asm volatile("s_waitcnt lgkmcnt(0)" ::: "memory");
    if (t_kind == 0) { const int c = lane & 7;
#pragma unroll
        for (int j = 0; j < 4; ++j) { const int n = (lane >> 3) + 8 * j; const LAS float* sp = scr + (8 * c) * 33 + n;
            u32x4 o; o.x = cvt_pk_bf16(sp[0 * 33], sp[1 * 33]); o.y = cvt_pk_bf16(sp[2 * 33], sp[3 * 33]); o.z = cvt_pk_bf16(sp[4 * 33], sp[5 * 33]); o.w = cvt_pk_bf16(sp[6 * 33], sp[7 * 33]);
            *(u32x4*)((bf16_t*)t_dst + (size_t)(t_n0 + n) * t_K + t_k0 + 8 * c) = o; } }
    else { const int c = lane & 3;
#pragma unroll
        for (int j = 0; j < 2; ++j) { const int n = (lane >> 2) + 16 * j; const LAS float* sp = scr + (16 * c) * 33 + n;
            u32x4 o; o.x = pack4_fp8(sp[0 * 33], sp[1 * 33], sp[2 * 33], sp[3 * 33]); o.y = pack4_fp8(sp[4 * 33], sp[5 * 33], sp[6 * 33], sp[7 * 33]);
            o.z = pack4_fp8(sp[8 * 33], sp[9 * 33], sp[10 * 33], sp[11 * 33]); o.w = pack4_fp8(sp[12 * 33], sp[13 * 33], sp[14 * 33], sp[15 * 33]);
            *(u32x4*)(t_dst + (size_t)(t_n0 + n) * t_K + t_k0 + 16 * c) = o; } }
    asm volatile("s_waitcnt lgkmcnt(0)" ::: "memory");
}
#define AS4 __attribute__((address_space(4)))
#define PP const AS4 Args* ap = (const AS4 Args*)__builtin_amdgcn_kernarg_segment_ptr(); asm volatile("" : "+s"(ap)); \
    int tid_o = threadIdx.x; asm volatile("" : "+v"(tid_o)); const int tid = tid_o, lane = tid & 63; (void)tid; (void)lane; \
    unsigned char* ws = ap->ws; float* out = ap->out; (void)out; \
    float* ss1 = (float*)(ws + WS_SS); float* ss2 = ss1 + NTOK; float* ss3 = ss2 + NTOK; (void)ss1; (void)ss2; (void)ss3; \
    bf16_t* Win_t = (bf16_t*)(ws + WS_WIN); bf16_t* Wpa_t = (bf16_t*)(ws + WS_WPA); bf16_t* Wpb_t = (bf16_t*)(ws + WS_WPB); bf16_t* Wo_t = (bf16_t*)(ws + WS_WO); \
    bf16_t* Wcq_t = (bf16_t*)(ws + WS_WCQ); bf16_t* Wckv_t = (bf16_t*)(ws + WS_WCKV); bf16_t* Wco_t = (bf16_t*)(ws + WS_WCO); \
    bf16_t* Wup_t = (bf16_t*)(ws + WS_WUP); bf16_t* Wdn_t = (bf16_t*)(ws + WS_WDN); \
    bf16_t* memn = (bf16_t*)(ws + WS_MEMN); bf16_t* memkv = (bf16_t*)(ws + WS_MEMKV); \
    bf16_t* XB = (bf16_t*)(ws + WS_XB); bf16_t* QC = (bf16_t*)(ws + WS_QC); bf16_t* Z = (bf16_t*)(ws + WS_Z); bf16_t* HB = (bf16_t*)(ws + WS_Z); unsigned char* XN8 = ws + WS_XN8; unsigned char* Win8 = ws + WS_WIN; (void)XN8; (void)Win8; \
    unsigned char* Q8 = ws + WS_QC; unsigned char* K8 = ws + WS_QC + 32 * MiB; unsigned char* VT8 = ws + WS_QC + 40 * MiB; (void)Q8; (void)K8; (void)VT8; \
    unsigned char* O8A = ws + WS_O8A; unsigned char* O8B = ws + WS_O8B; unsigned char* M8 = (unsigned char*)(Z + Z_NAK); (void)O8A; (void)O8B; (void)M8; \
    (void)Win_t; (void)Wpa_t; (void)Wpb_t; (void)Wo_t; (void)Wcq_t; (void)Wckv_t; (void)Wco_t; (void)Wup_t; (void)Wdn_t; (void)memn; (void)memkv; (void)XB; (void)QC; (void)Z; (void)HB;
__global__ void __launch_bounds__(NWAVES * 64, 2) mega_fwd(Args args) {
    extern __shared__ __attribute__((aligned(16))) unsigned char lds[];
    LAS unsigned char* L = (LAS unsigned char*)lds;
    cg::grid_group grid = cg::this_grid();
    const int tid = threadIdx.x, lane = tid & 63, wave = __builtin_amdgcn_readfirstlane(tid >> 6);
    const int G = gridDim.x, bx = blockIdx.x;
    const int vcu = (G % 8 == 0) ? (bx % 8) * (G / 8) + bx / 8 : bx;
    const int gw = vcu * NWAVES + wave, NGW = G * NWAVES;
    const int lo = args.ph_lo, hi = args.ph_hi; int ph = 0;
    volatile LAS unsigned* bst = (volatile LAS unsigned*)(L + LDS_MISC_OFF);
    if (threadIdx.x < 4) bst[threadIdx.x] = 0u;
    __syncthreads();
    XcdBarrier xbar; xbar.bar = (unsigned*)(args.ws + WS_BAR); xbar.x = 0; xbar.st = bst;
    if (hi - lo > 1) xbar = xcd_barrier_post((unsigned*)(args.ws + WS_BAR), bst);
#ifndef PH_MASK
#define PH_MASK 0xffff
#endif
#ifndef DUP_P0
#define DUP_P0 0
#endif
#ifndef DUP_A
#define DUP_A 0
#endif
#ifndef DUP_GQA
#define DUP_GQA 0
#endif
#ifndef DUP_NA
#define DUP_NA 0
#endif
#ifndef DUP_I
#define DUP_I 0
#endif
#ifndef DUP_SYNC
#define DUP_SYNC 0
#endif
#ifndef DUP_G
#define DUP_G 0
#endif
#ifndef DUP_F
#define DUP_F 0
#endif
#define PHON(b) ((PH_MASK >> (b)) & 1)
#define RUN() (ph >= lo && ph < hi)
#define SEAM() do { if (ph >= lo && ph + 1 < hi) { if (lo < 0) grid.sync(); else xcd_barrier(xbar); for (int r_ = 0; r_ < DUP_SYNC; ++r_) xcd_barrier(xbar); } ++ph; } while (0)

    if (PHON(0) && RUN()) { PP
      _Pragma("unroll 1") for (int rep = 0; rep <= DUP_P0; ++rep) {
        for (int i = gw * 64 + lane; i < 3 * NTOK; i += NGW * 64) ss1[i] = 0.f;
        LAS float* scr = (LAS float*)(L + wave * 16384);
        constexpr int I_IN = (DM / 64) * (DIN / 32), I_PA = (1024 / 64) * (DM / 32), I_O = (DM / 64) * (DM / 32), I_CQ = (DM / 64) * (CWID / 32), I_CKV = (DM / 64) * (1024 / 32),
                      I_CO = (CWID / 64) * (DM / 32), I_UP = (DM / 64) * (DFF / 32), I_DN = (DFF / 64) * (DM / 32);
        constexpr int NITEMS = I_IN + 2 * I_PA + I_O + I_CQ + I_CKV + I_CO + I_UP + I_DN;
        const float W8M = (float)(1 << W8_SHIFT);
#define TI_VARS(P) const float* P##src = nullptr; int P##ldw = 0, P##K = 0, P##k0 = 0, P##n0 = 0, P##kind = 0; const float* P##gain = nullptr; float P##mul = 1.f; unsigned char* P##dst = nullptr; f32x4 P##w[8]
#define TI_REFS(P) P##src, P##ldw, P##K, P##k0, P##n0, P##kind, P##gain, P##mul, P##dst
#define TI_DECODE(P, it_) do { int r = (it_); \
            if (r < I_IN) { ti_set(TI_REFS(P), ap->in[5], DM, DIN, Win8, ap->in[4], W8M, 1, r); break; } r -= I_IN; \
            if (r < I_PA) { ti_set(TI_REFS(P), ap->in[9], 1024, DM, Wpa_t, nullptr, W8M, 1, r); break; } r -= I_PA; \
            if (r < I_PA) { ti_set(TI_REFS(P), ap->in[10], 1024, DM, Wpb_t, nullptr, W8M, 1, r); break; } r -= I_PA; \
            if (r < I_O) { ti_set(TI_REFS(P), ap->in[11], DM, DM, Wo_t, nullptr, W8M, 1, r); break; } r -= I_O; \
            if (r < I_CQ) { ti_set(TI_REFS(P), ap->in[14], DM, CWID, Wcq_t, ap->in[12], 1.0f, 0, r); break; } r -= I_CQ; \
            if (r < I_CKV) { ti_set(TI_REFS(P), ap->in[15], DM, 1024, Wckv_t, ap->in[13], 1.0f, 0, r); break; } r -= I_CKV; \
            if (r < I_CO) { ti_set(TI_REFS(P), ap->in[16], CWID, DM, Wco_t, nullptr, 1.0f, 0, r); break; } r -= I_CO; \
            if (r < I_UP) { ti_set(TI_REFS(P), ap->in[18], DM, DFF, Wup_t, ap->in[17], 1.0f, 0, r); break; } r -= I_UP; \
            ti_set(TI_REFS(P), ap->in[19], DFF, DM, Wdn_t, nullptr, 1.0f, 0, r); } while (0)
#define TI_LOAD(P) ti_load(P##w, P##src, P##ldw, P##k0, P##n0, lane)
#define TI_PROC(P) ti_process(P##w, P##K, P##k0, P##n0, P##kind, P##gain, P##mul, P##dst, scr, lane)
        { TI_VARS(ta_); TI_VARS(tb_); int it = gw;
          if (it < NITEMS) { TI_DECODE(ta_, it); TI_LOAD(ta_); }
          while (it < NITEMS) {
              const int it2 = it + NGW; const bool hb = it2 < NITEMS; if (hb) { TI_DECODE(tb_, it2); TI_LOAD(tb_); }
              TI_PROC(ta_); if (!hb) break;
              const int it3 = it2 + NGW; const bool ha = it3 < NITEMS; if (ha) { TI_DECODE(ta_, it3); TI_LOAD(ta_); }
              TI_PROC(tb_); if (!ha) break;
              it = it3; } }
#undef TI_DECODE
#undef TI_VARS
#undef TI_REFS
#undef TI_LOAD
#undef TI_PROC
        for (int m = gw; m < NTOK; m += 2 * NGW) {
            const int m2 = m + NGW; const float* xa = (m < 32768) ? ap->in[0] + (size_t)m * DM : ap->in[1] + (size_t)(m - 32768) * DM;
            if (m2 < NTOK) { const float* xb2 = (m2 < 32768) ? ap->in[0] + (size_t)m2 * DM : ap->in[1] + (size_t)(m2 - 32768) * DM; rms_row2_to_fp8(xa, xb2, XN8 + (size_t)m * DM, XN8 + (size_t)m2 * DM, lane); }
            else rms_row_to_fp8(xa, XN8 + (size_t)m * DM, lane); }
        for (int m = gw; m < NMEMROWS; m += NGW) { const float* xr = (m < 1024) ? ap->in[2] + (size_t)m * DM : ap->in[3] + (size_t)(m - 1024) * DM; rms_row_to_bf16(xr, memn + (size_t)m * DM, lane); }
      }
    }
    SEAM();

#pragma unroll 1
    for (int c = 0; c < NCH; ++c) {
        const int row0 = c * 32768, CR = (c == 0) ? 32768 : 16384, nb = (c == 0) ? 4 : 1, seq = (c == 0) ? 8192 : 16384;
        if (PHON(1) && RUN()) { PP
            pg8::Gemm g{(const bf16_t*)(XN8 + (size_t)row0 * DM), (const bf16_t*)Win8, CR, DIN, DM / 2, DM / 2, 0}; pg8::StaticOrder S; S.init(CR, DIN, G, bx, 4);
            pg8::EpiB E{Z, 0, 1, nullptr, 0};
            _Pragma("unroll 1") for (int rep = 0; rep <= DUP_A; ++rep)
            pg8::gemm_phase<pg8::EpiB, pg8::StaticOrder, true>(L, g, S, E);
        }
        SEAM();
        if (PHON(2) && RUN()) { PP
            rope_pass(Z + Z_GQ, Q8, 1024, CR, seq, ap->in[7], att::QPRE, gw, NGW, lane);
            rope_pass(Z + Z_GK, K8, 256, CR, seq, ap->in[8], 1.0f, gw, NGW, lane);
            vt_pass(Z + Z_GV, VT8, CR, seq, gw, NGW, lane);
        }
        SEAM();
        if (PHON(3) && RUN()) { PP
            const int nqb = seq / 256, NU = nb * 8 * nqb, nper = (NU + G - 1) / G;
            att::NaCtx na0{0, 0, 0, 0, 0, nullptr};
            bf16_t* DUMMY = (bf16_t*)(ws + 981 * MiB); (void)DUMMY;
            _Pragma("unroll 1") for (int rep = 0; rep <= DUP_GQA; ++rep)
            for (int i = 0; i < nper; ++i) { const int u = vcu * nper + i; if (u >= NU) break;
                const int qb = u % nqb; int t = u / nqb; const int gq = t % 4; t /= 4; const int kvh = t % 2, b = t / 2, h = kvh * 4 + gq;
                const size_t qoff = ((size_t)b * seq + (size_t)qb * 256) * 1024 + h * 128;
                att::attn_body_f8<1024, 256, 1024, OB_SHIFT>(Q8 + qoff, K8 + (size_t)b * seq * 256 + kvh * 128, VT8 + ((size_t)(b * 2 + kvh) * 128) * (size_t)seq, (long)seq, O8B + qoff, seq, (char*)lds);
            }
            __syncthreads();
            const int rows = seq / 64;
            _Pragma("unroll 1") for (int rep = 0; rep <= DUP_NA; ++rep)
            for (int i = 0; i < nper; ++i) { const int u = vcu * nper + i; if (u >= NU) break;
                const int h = u % 8; int t = u / 8; const int rg = t % nqb, b = t / nqb, R0 = 4 * rg;
                int kr0 = R0 - 4; kr0 = kr0 < 0 ? 0 : (kr0 > rows - 12 ? rows - 12 : kr0);
                LAS float* tb = (LAS float*)(L + att::NA_TBL_OFF) + att::NA_TBL_PAD;
                if (tid < 15 * 32) { const int dr = tid >> 5, dc = tid & 31; tb[tid] = (dc < 31) ? ap->in[6][(h * 15 + dr) * 31 + dc] * (1.0f / att::SCALE) : 0.f; }
                att::NaCtx na; na.r = R0 + (wave >> 1); na.rs = na.r - 4 < 0 ? 0 : (na.r - 4 > rows - 8 ? rows - 8 : na.r - 4);
                na.c = (wave & 1) * 32 + (lane & 31); na.cs = na.c - 8 < 0 ? 0 : (na.c - 8 > 48 ? 48 : na.c - 8); na.kr0 = kr0; na.tbl = tb;
                bf16_t* Q = Z + Z_NAQ + ((size_t)b * seq + (size_t)R0 * 64) * 1024 + h * 128;
                const bf16_t* Kp = Z + Z_NAK + ((size_t)b * seq + (size_t)kr0 * 64) * 1024 + h * 128; const bf16_t* Vp = Z + Z_NAV + ((size_t)b * seq + (size_t)kr0 * 64) * 1024 + h * 128;
                att::attn_body<1024, 1024, 1024, true, OA_SHIFT>(Q, Kp, Vp, (bf16_t*)(O8A + ((size_t)b * seq + (size_t)R0 * 64) * 1024 + h * 128), 12 * 64, (char*)lds, na);
            }
            __syncthreads();
        }
        SEAM();
        if (PHON(4) && RUN()) { PP
            { pg8::Gemm g{(const bf16_t*)O8A, Wpa_t, CR, DM, 512, 512, OA_SHIFT}; pg8::StaticOrder S; S.init(CR, DM, G, bx);
              pg8::EpiGate E{Z + Z_GA, Z + Z_GA, nullptr, 0}; pg8::gemm_phase<pg8::EpiGate, pg8::StaticOrder, true>(L, g, S, E); }
            { pg8::Gemm g{(const bf16_t*)O8B, Wpb_t, CR, DM, 512, 512, OB_SHIFT}; pg8::StaticOrder S; S.init(CR, DM, G, bx);
              pg8::EpiGate E{Z + Z_GB, Z + Z_GA, M8, 1}; pg8::gemm_phase<pg8::EpiGate, pg8::StaticOrder, true>(L, g, S, E); }
        }
        SEAM();
        if (PHON(5) && RUN()) { PP
            const float* xin = (c == 0) ? ap->in[0] : ap->in[1];
            pg8::Gemm g{(const bf16_t*)M8, Wo_t, CR, DM, DM / 2, DM / 2, MX_SHIFT}; pg8::StaticOrder S; S.init(CR, DM, G, bx);
            pg8::EpiRes<true> E{xin, nullptr, XB + (size_t)row0 * DM, ss1 + row0};
            pg8::gemm_phase<pg8::EpiRes<true>, pg8::StaticOrder, true>(L, g, S, E);
        }
        SEAM();
    }
    if (PHON(6) && RUN()) { PP
        { pg8::Gemm g{XB, Wcq_t, NTOK, CWID, DM, DM, 0}; pg8::StaticOrder S; S.init(NTOK, CWID, G, bx);
          pg8::EpiB E{QC, CWID, 0, ss1, 0};
          _Pragma("unroll 1") for (int rep = 0; rep <= DUP_F; ++rep)
          pg8::gemm_phase<pg8::EpiB, pg8::StaticOrder>(L, g, S, E); }
        { pg8::Gemm g{memn, Wckv_t, NMEMROWS, 1024, DM, DM, 0}; pg8::StaticOrder S; S.init(NMEMROWS, 1024, G, (bx + G / 2) % G);
          pg8::EpiB E{memkv, 1024, 0, nullptr, 0}; pg8::gemm_phase<pg8::EpiB, pg8::StaticOrder>(L, g, S, E); }
    }
    SEAM();
    if (PHON(7) && RUN()) { PP
        const int NU = (NTOK / 256) * 4, nper = (NU + G - 1) / G;
        att::NaCtx na0{0, 0, 0, 0, 0, nullptr};
        bf16_t* DUMMY = (bf16_t*)(ws + 981 * MiB); (void)DUMMY;
        _Pragma("unroll 1") for (int rep = 0; rep <= DUP_G; ++rep)
        for (int i = 0; i < nper; ++i) { const int u = vcu * nper + i; if (u >= NU) break;
            const int h = u % 4, rb = u / 4, b = (rb < 128) ? (rb >> 5) : 4;
            bf16_t* Q = QC + (size_t)rb * 256 * CWID + h * 128;
            const bf16_t* Kp = memkv + (size_t)b * 256 * 1024 + h * 128; const bf16_t* Vp = Kp + 512;
            att::attn_body<512, 1024, 512, false>(Q, Kp, Vp, (rep < DUP_G) ? DUMMY + (Q - QC) : Q, 256, (char*)lds, na0);
        }
        __syncthreads();
    }
    SEAM();
    if (PHON(8) && RUN()) { PP
        pg8::Gemm g{QC, Wco_t, NTOK, DM, CWID, CWID, 0}; pg8::StaticOrder S; S.init(NTOK, DM, G, bx);
        pg8::EpiRes<false> E{nullptr, XB, XB, ss2}; pg8::gemm_phase<pg8::EpiRes<false>, pg8::StaticOrder>(L, g, S, E);
    }
    SEAM();
#pragma unroll 1
    for (int c = 0; c < NCH; ++c) {
        const int row0 = c * 32768, CR = (c == 0) ? 32768 : 16384;
        if (PHON(9) && RUN()) { PP
            pg8::Gemm g{XB + (size_t)row0 * DM, Wup_t, CR, DFF, DM, DM, 0}; pg8::StaticOrder S; S.init(CR, DFF, G, bx);
            pg8::EpiB E{HB, DFF, 0, ss2 + row0, 1};
            _Pragma("unroll 1") for (int rep = 0; rep <= DUP_I; ++rep)
            pg8::gemm_phase<pg8::EpiB, pg8::StaticOrder>(L, g, S, E);
        }
        SEAM();
        if (PHON(10) && RUN()) { PP
            pg8::Gemm g{HB, Wdn_t, CR, DM, DFF, DFF, 0}; pg8::StaticOrder S; S.init(CR, DM, G, bx);
            pg8::EpiRes<false> E{nullptr, XB + (size_t)row0 * DM, XB + (size_t)row0 * DM, ss3 + row0}; pg8::gemm_phase<pg8::EpiRes<false>, pg8::StaticOrder>(L, g, S, E);
        }
        SEAM();
    }
    if (PHON(11) && RUN()) { PP
        const float* gf = ap->in[20];
        f32x4 gv[8];
#pragma unroll
        for (int j = 0; j < 8; ++j) gv[j] = *((const f32x4*)gf + lane + 64 * j);
        for (int m = gw; m < NTOK; m += NGW) { const float rr = __builtin_amdgcn_rsqf(ss3[m] * (1.f / DM) + EPS);
            const u32x2* xb = (const u32x2*)(XB + (size_t)m * DM) + lane; f32x4* xr = (f32x4*)(out + (size_t)m * DM) + lane;
            u32x2 r[8];
#pragma unroll
            for (int j = 0; j < 8; ++j) r[j] = xb[64 * j];
#pragma unroll
            for (int j = 0; j < 8; ++j) { f32x4 v = (f32x4){bf_lo(r[j].x), bf_hi(r[j].x), bf_lo(r[j].y), bf_hi(r[j].y)}; v = v * rr * gv[j]; xr[64 * j] = v; } }
    }
#undef RUN
#undef SEAM
}

extern "C" void kernel_launch(void* const* d_in, const int* in_sizes, int n_in, void* d_out, int out_size, void* d_ws, size_t ws_size, hipStream_t stream) {
    static int grid = 0;
    if (grid == 0) {
        if (n_in != 21 || out_size != NTOK * DM || ws_size < WS_END) { fprintf(stderr, "kernel_launch: unexpected shapes n_in %d out %d ws %zu\n", n_in, out_size, ws_size); grid = -1; return; }
        int dev = 0, cus = 0, per_cu = 0;
        if (hipGetDevice(&dev) != hipSuccess || hipDeviceGetAttribute(&cus, hipDeviceAttributeMultiprocessorCount, dev) != hipSuccess) { grid = -1; return; }
        if (hipFuncSetAttribute((const void*)mega_fwd, hipFuncAttributeMaxDynamicSharedMemorySize, LDS_BYTES) != hipSuccess) { fprintf(stderr, "kernel_launch: hipFuncSetAttribute failed\n"); grid = -1; return; }
        if (hipOccupancyMaxActiveBlocksPerMultiprocessor(&per_cu, (const void*)mega_fwd, NWAVES * 64, LDS_BYTES) != hipSuccess || per_cu < 1) per_cu = 1;
        (void)hipGetLastError();
        grid = cus * 1;
        (void)per_cu;
    }
    if (grid < 0) return;
    Args a{};
    for (int i = 0; i < 21; ++i) a.in[i] = (const float*)d_in[i];
    a.out = (float*)d_out; a.ws = (unsigned char*)d_ws;
#if MK_MULTI
    for (int p = 0; p < NPH; ++p) { a.ph_lo = p; a.ph_hi = p + 1; hipLaunchKernelGGL(mega_fwd, dim3(grid), dim3(NWAVES * 64), LDS_BYTES, stream, a); }
#else
    a.ph_lo = 0; a.ph_hi = NPH;
    if (hipMemsetAsync((char*)d_ws + WS_BAR, 0, XCD_BAR_WORDS * 4, stream) != hipSuccess) { fprintf(stderr, "kernel_launch: memset of barrier words failed\n"); return; }
    void* kargs[] = {&a};
    hipError_t e = hipLaunchCooperativeKernel((const void*)mega_fwd, dim3(grid), dim3(NWAVES * 64), kargs, LDS_BYTES, stream);
    if (e != hipSuccess) fprintf(stderr, "cooperative launch failed: %s (grid %d)\n", hipGetErrorString(e), grid);
#endif
}
```
